# Optimizing an MI355X kernel written in HIP

```python
import math
import jax
import jax.numpy as jnp
from jax import lax
import numpy as np

D_MODEL = 1024
BATCH = 2
SEQ = 16384
DEPTH = 2

F32 = jnp.float32
CTX_LEN = 256
GRID_W = 64
CHUNK = 64
NORM_EPS = 1e-6
HEAD_NORM_EPS = 1e-5

N_RET_HEADS = 4
RET_DK = 64
RET_DV = 128
RET_QK = N_RET_HEADS * RET_DK
RET_V = N_RET_HEADS * RET_DV
RET_LOG_DECAY_FWD = tuple(math.log1p(-2.0 ** (-5.0 - h)) for h in range(N_RET_HEADS))
RET_LOG_DECAY_BWD = tuple(math.log1p(-2.0 ** (-5.5 - h)) for h in range(N_RET_HEADS))

N_GLA_HEADS = 4
GLA_DK = 64
GLA_DV = 128
GLA_QK = N_GLA_HEADS * GLA_DK
GLA_V = N_GLA_HEADS * GLA_DV
GLA_LOWRANK = 16
GLA_GATE_NORM = 16.0

D_HY = 512
HY_BANDS = 16
HY_EMB = 1 + 2 * HY_BANDS
HY_FILTER_WIDTH = 64
HY_INNER = 2
HY_TARGET = 1e-2
HY_FAST_PCT = 0.3
HY_SLOW_PCT = 1.5
HY_MIN_DECAY = math.log(HY_TARGET) / HY_SLOW_PCT
HY_MAX_DECAY = math.log(HY_TARGET) / HY_FAST_PCT
HY_SHIFT = 0.05
HY_FILTER_INIT = 0.05

N_BRANCH = 3
BRANCH_W = 512
D_FF = 2816

IN_SPLITS = (RET_QK, RET_QK, RET_V, RET_V, GLA_QK, GLA_QK, GLA_V, GLA_V, 2 * GLA_LOWRANK, 3 * D_HY, N_BRANCH * D_MODEL)
D_IN = sum(IN_SPLITS)
IN_OFFSETS = tuple(sum(IN_SPLITS[:i + 1]) for i in range(len(IN_SPLITS) - 1))

kernel_name = 'hybrid_ret_gla_hyena_dit'


def rms_norm(x, g):
    xf = x.astype(F32)
    y = xf * lax.rsqrt(jnp.mean(xf * xf, axis=-1, keepdims=True) + NORM_EPS)
    return (y * g.astype(F32)).astype(x.dtype)


def modulate(x, g, shift, scale):
    return rms_norm(x, g) * (1.0 + scale) + shift


def head_norm(o):
    mu = jnp.mean(o, axis=-1, keepdims=True)
    var = jnp.mean(jnp.square(o - mu), axis=-1, keepdims=True)
    return (o - mu) * lax.rsqrt(var + HEAD_NORM_EPS)


def to_heads(z, n):
    b, t, w = z.shape
    return z.reshape(b, t, n, w // n).transpose(0, 2, 1, 3)


def from_heads(z):
    b, n, t, d = z.shape
    return z.transpose(0, 2, 1, 3).reshape(b, t, n * d)


def dwconv1d(z, w, bias):
    L = z.shape[1]
    zp = jnp.pad(z, ((0, 0), (1, 1), (0, 0)))
    return bias + zp[:, :L] * w[0] + zp[:, 1:L + 1] * w[1] + zp[:, 2:] * w[2]


def dwconv2d(z, w, bias):
    R, W = z.shape[1], z.shape[2]
    zp = jnp.pad(z, ((0, 0), (1, 1), (1, 1), (0, 0)))
    out = bias
    for i in range(3):
        for j in range(3):
            out = out + zp[:, i:i + R, j:j + W] * w[i, j]
    return out


def chunked_scan(q, k, v, log_a, h0, strict, need_out=True):
    q, k, v, log_a = (z.astype(F32) for z in (q, k, v, log_a))
    b_, h_, t, _ = q.shape
    dv = v.shape[-1]
    n = t // CHUNK
    split = lambda z: z.reshape(b_, h_, n, CHUNK, z.shape[-1])
    qc, kc, vc, la = split(q), split(k), split(v), split(log_a)
    cum = jnp.cumsum(la, axis=3)
    cum_last = cum[:, :, :, -1:]
    k_out = kc * jnp.exp(cum_last - cum)
    a_chunk = jnp.exp(cum_last[:, :, :, 0])
    lead = lambda z: jnp.moveaxis(z, 2, 0)
    xs = (lead(k_out), lead(vc), lead(a_chunk))
    if need_out:
        q_in = qc * jnp.exp(cum)
        idx = jnp.arange(CHUNK)
        mask = idx[:, None] > idx[None, :] if strict else idx[:, None] >= idx[None, :]
        if la.shape[-1] == 1:
            cs = cum[..., 0]
            diff = jnp.where(mask, cs[..., :, None] - cs[..., None, :], 0.0)
            decay = jnp.where(mask, jnp.exp(diff), 0.0)
            scores = jnp.einsum('bhncd,bhnsd->bhncs', qc, kc) * decay
        else:
            scores = jnp.einsum('bhncd,bhnsd->bhncs', q_in, kc * jnp.exp(-cum))
            scores = jnp.where(mask, scores, 0.0)
        o_intra = jnp.einsum('bhncs,bhnse->bhnce', scores, vc)
        xs = xs + (lead(q_in),)

    def step(h, xs_i):
        ki, vi, ai = xs_i[:3]
        o = jnp.einsum('bhcd,bhde->bhce', xs_i[3], h) if need_out else None
        h_new = ai[..., None] * h + jnp.einsum('bhcd,bhce->bhde', ki, vi)
        return h_new, o

    h_t, o_inter = lax.scan(step, h0, xs)
    if not need_out:
        return None, h_t
    o = o_intra + jnp.moveaxis(o_inter, 0, 2)
    return o.reshape(b_, h_, t, dv), h_t


def bidir_recurrence(ctx_qkv, lat_qkv, ctx_log_a, lat_log_a, need_ctx_out):
    bsz, nh, _, dk = ctx_qkv[0].shape
    dv = ctx_qkv[2].shape[-1]
    o_ctx, o_lat = None, None
    for d in range(2):
        rev = d == 1
        f = (lambda z: jnp.flip(z, axis=2)) if rev else (lambda z: z)
        h0 = jnp.zeros((bsz, nh, dk, dv), F32)
        oc, hc = chunked_scan(*[f(z) for z in ctx_qkv], f(ctx_log_a[d]), h0, rev, need_ctx_out)
        ol, _ = chunked_scan(*[f(z) for z in lat_qkv], f(lat_log_a[d]), hc, rev)
        o_lat = f(ol) if o_lat is None else o_lat + f(ol)
        if need_ctx_out:
            o_ctx = f(oc) if o_ctx is None else o_ctx + f(oc)
    return o_ctx, o_lat


def retention_branch(p_ctx, p_lat, need_ctx_out):
    def prep(q, k, v):
        return (to_heads(q, N_RET_HEADS).astype(F32),
                to_heads(k, N_RET_HEADS).astype(F32) * RET_DK ** -0.5,
                to_heads(v, N_RET_HEADS).astype(F32))

    def log_decay(q):
        b, h, t, _ = q.shape
        return tuple(jnp.broadcast_to(jnp.asarray(g, F32)[None, :, None, None], (b, h, t, 1))
                     for g in (RET_LOG_DECAY_FWD, RET_LOG_DECAY_BWD))

    qkv_c, qkv_l = prep(*p_ctx[:3]), prep(*p_lat[:3])
    o_c, o_l = bidir_recurrence(qkv_c, qkv_l, log_decay(qkv_c[0]), log_decay(qkv_l[0]), need_ctx_out)
    out = lambda o, g: from_heads(head_norm(o)) * jax.nn.silu(g.astype(F32))
    return (out(o_c, p_ctx[3]) if need_ctx_out else None), out(o_l, p_lat[3])


def gla_branch(p_ctx, p_lat, wa2, ba, need_ctx_out):
    def prep(q, k, v, r, lr):
        qkv = (to_heads(q, N_GLA_HEADS).astype(F32) * GLA_DK ** -0.5,
               to_heads(k, N_GLA_HEADS).astype(F32),
               to_heads(v, N_GLA_HEADS).astype(F32))
        lr_dirs = jnp.split(lr.astype(F32), 2, axis=-1)
        log_a = tuple(to_heads(jax.nn.log_sigmoid(lr_dirs[d] @ wa2[d] + ba[d]) / GLA_GATE_NORM, N_GLA_HEADS)
                      for d in range(2))
        return qkv, log_a

    qkv_c, la_c = prep(*p_ctx)
    qkv_l, la_l = prep(*p_lat)
    o_c, o_l = bidir_recurrence(qkv_c, qkv_l, la_c, la_l, need_ctx_out)
    out = lambda o, r: from_heads(head_norm(o)) * jax.nn.silu(r.astype(F32))
    return (out(o_c, p_ctx[3]) if need_ctx_out else None), out(o_l, p_lat[3])


def hyena_filters(length, w1, b1, w2, b2, w3, freq):
    t = jnp.linspace(0.0, 1.0, length, dtype=F32)[:, None]
    ang = (2.0 * math.pi / length) * jnp.arange(length, dtype=F32)[:, None] \
        * jnp.linspace(1e-4, HY_BANDS - 1.0, HY_BANDS, dtype=F32)[None, :]
    z = jnp.concatenate([t, jnp.cos(ang), -jnp.sin(ang)], axis=-1)
    hdn = jnp.sin(freq * (z @ w1 + b1))
    for i in range(HY_INNER):
        hdn = jnp.sin(freq * (hdn @ w2[i] + b2[i]))
    h = (hdn @ w3).reshape(length, 2, D_HY)
    deltas = jnp.abs(jnp.linspace(HY_MIN_DECAY, HY_MAX_DECAY, D_HY, dtype=F32))
    window = jnp.exp(-t * deltas) + HY_SHIFT
    h = h * window[:, None, :]
    return h[:, 0], h[:, 1]


def fft_long_conv(z, h_fwd, h_bwd):
    L = z.shape[1]
    k = jnp.concatenate([h_fwd, jnp.zeros_like(h_fwd[:1]), jnp.flip(h_bwd[1:], axis=0)], axis=0)
    zf = jnp.fft.rfft(z, n=2 * L, axis=1)
    kf = jnp.fft.rfft(k, axis=0)
    return jnp.fft.irfft(zf * kf[None], n=2 * L, axis=1)[:, :L]


def hyena_branch(p, h_fwd, h_bwd, short_w, short_b, bias):
    u = dwconv1d(p, short_w, short_b)
    x0, x1, v = jnp.split(u, 3, axis=-1)
    z = (x1 * v).astype(F32)
    y = fft_long_conv(z, h_fwd, h_bwd) + z * bias
    return x0.astype(F32) * y


def merge_branches(branches, gate_logits, w_branch, w_out):
    gates = jnp.split(jax.nn.sigmoid(gate_logits.astype(F32)), N_BRANCH, axis=-1)
    mixed = gates[0] * (branches[0] @ w_branch[0])
    for g in range(1, N_BRANCH):
        mixed = mixed + gates[g] * (branches[g] @ w_branch[g])
    return mixed @ w_out


def token_mixer(h_ctx, h_lat, lp, need_ctx_out):
    p_ctx = jnp.split(h_ctx @ lp['w_in'], IN_OFFSETS, axis=-1)
    p_lat = jnp.split(h_lat @ lp['w_in'], IN_OFFSETS, axis=-1)
    ret_c, ret_l = retention_branch(p_ctx[0:4], p_lat[0:4], need_ctx_out)
    gla_c, gla_l = gla_branch(p_ctx[4:9], p_lat[4:9], lp['gla_wa2'], lp['gla_ba'], need_ctx_out)
    filt = (lp['hy_w1'], lp['hy_b1'], lp['hy_w2'], lp['hy_b2'], lp['hy_w3'], lp['hy_freq'])
    hy_args = (lp['hy_short_w'], lp['hy_short_b'], lp['hy_bias'])
    hy_l = hyena_branch(p_lat[9], *hyena_filters(h_lat.shape[1], *filt), *hy_args)
    mix_l = merge_branches((ret_l, gla_l, hy_l), p_lat[10], lp['w_branch'], lp['w_out'])
    if not need_ctx_out:
        return None, mix_l
    hy_c = hyena_branch(p_ctx[9], *hyena_filters(h_ctx.shape[1], *filt), *hy_args)
    mix_c = merge_branches((ret_c, gla_c, hy_c), p_ctx[10], lp['w_branch'], lp['w_out'])
    return mix_c, mix_l


def conv_glu(h, rows, cols, lp):
    b, t, _ = h.shape
    a, v = jnp.split(h @ lp['w_up'], 2, axis=-1)
    a = dwconv2d(a.reshape(b, rows, cols, D_FF), lp['ffn_conv_w'], lp['ffn_conv_b']).reshape(b, t, D_FF)
    return (jax.nn.gelu(a, approximate=False) * v) @ lp['w_down']


def setup_inputs(seed: int = 0) -> dict:
    key = jax.random.key(seed)
    ks = iter(jax.random.split(key, 32))
    nrm = lambda shape, s: s * jax.random.normal(next(ks), shape, F32)
    L = DEPTH
    return {
        'x': nrm((BATCH, SEQ, D_MODEL), 1.0),
        'c': nrm((BATCH, D_MODEL), 1.0),
        'ctx': nrm((BATCH, CTX_LEN, D_MODEL), 1.0),
        'c_ctx': nrm((D_MODEL,), 1.0),
        'ada_w': nrm((L, D_MODEL, 6 * D_MODEL), 0.5 * D_MODEL ** -0.5),
        'ada_b': nrm((L, 6 * D_MODEL), 0.02),
        'norm1_g': 1.0 + nrm((L, D_MODEL), 0.02),
        'w_in': nrm((L, D_MODEL, D_IN), D_MODEL ** -0.5),
        'gla_wa2': nrm((L, 2, GLA_LOWRANK, GLA_QK), GLA_LOWRANK ** -0.5),
        'gla_ba': nrm((L, 2, GLA_QK), 0.1),
        'hy_short_w': nrm((L, 3, 3 * D_HY), 3 ** -0.5),
        'hy_short_b': nrm((L, 3 * D_HY), 0.02),
        'hy_w1': nrm((L, HY_EMB, HY_FILTER_WIDTH), HY_EMB ** -0.5),
        'hy_b1': nrm((L, HY_FILTER_WIDTH), 0.1),
        'hy_w2': nrm((L, HY_INNER, HY_FILTER_WIDTH, HY_FILTER_WIDTH), HY_FILTER_WIDTH ** -0.5),
        'hy_b2': nrm((L, HY_INNER, HY_FILTER_WIDTH), 0.1),
        'hy_w3': nrm((L, HY_FILTER_WIDTH, 2 * D_HY), HY_FILTER_INIT * HY_FILTER_WIDTH ** -0.5),
        'hy_freq': 1.0 + nrm((L, HY_FILTER_WIDTH), 0.1),
        'hy_bias': nrm((L, D_HY), 1.0),
        'w_branch': nrm((L, N_BRANCH, BRANCH_W, D_MODEL), BRANCH_W ** -0.5),
        'w_out': nrm((L, D_MODEL, D_MODEL), D_MODEL ** -0.5),
        'norm2_g': 1.0 + nrm((L, D_MODEL), 0.02),
        'w_up': nrm((L, D_MODEL, 2 * D_FF), D_MODEL ** -0.5),
        'ffn_conv_w': nrm((L, 3, 3, D_FF), 1.0 / 3.0),
        'ffn_conv_b': nrm((L, D_FF), 0.02),
        'w_down': nrm((L, D_FF, D_MODEL), D_FF ** -0.5),
        'final_g': 1.0 + nrm((D_MODEL,), 0.02),
    }


def reference(x, c, ctx, c_ctx, ada_w, ada_b, norm1_g, w_in, gla_wa2, gla_ba, hy_short_w, hy_short_b,
              hy_w1, hy_b1, hy_w2, hy_b2, hy_w3, hy_freq, hy_bias, w_branch, w_out, norm2_g, w_up,
              ffn_conv_w, ffn_conv_b, w_down, final_g):
    rows = x.shape[1] // GRID_W
    x_lat, x_ctx = x, ctx
    s_lat = jax.nn.silu(c)
    s_ctx = jax.nn.silu(c_ctx)
    for l in range(DEPTH):
        last = l == DEPTH - 1
        lp = dict(w_in=w_in[l], gla_wa2=gla_wa2[l], gla_ba=gla_ba[l], hy_short_w=hy_short_w[l],
                  hy_short_b=hy_short_b[l], hy_w1=hy_w1[l], hy_b1=hy_b1[l], hy_w2=hy_w2[l], hy_b2=hy_b2[l],
                  hy_w3=hy_w3[l], hy_freq=hy_freq[l], hy_bias=hy_bias[l], w_branch=w_branch[l],
                  w_out=w_out[l], w_up=w_up[l], ffn_conv_w=ffn_conv_w[l], ffn_conv_b=ffn_conv_b[l],
                  w_down=w_down[l])
        sh1, sc1, g1, sh2, sc2, g2 = jnp.split((s_lat @ ada_w[l] + ada_b[l])[:, None, :], 6, axis=-1)
        csh1, csc1, cg1, csh2, csc2, cg2 = jnp.split(s_ctx @ ada_w[l] + ada_b[l], 6, axis=-1)
        h_lat = modulate(x_lat, norm1_g[l], sh1, sc1)
        h_ctx = modulate(x_ctx, norm1_g[l], csh1, csc1)
        mix_c, mix_l = token_mixer(h_ctx, h_lat, lp, not last)
        x_lat = x_lat + g1 * mix_l
        x_lat = x_lat + g2 * conv_glu(modulate(x_lat, norm2_g[l], sh2, sc2), rows, GRID_W, lp)
        if not last:
            x_ctx = x_ctx + cg1 * mix_c
            x_ctx = x_ctx + cg2 * conv_glu(modulate(x_ctx, norm2_g[l], csh2, csc2), 1, x_ctx.shape[1], lp)
    return rms_norm(x_lat, final_g)
```

```cpp
#include <hip/hip_runtime.h>
#include <hip/hip_cooperative_groups.h>
#include <cstdio>
#include <cstdint>
#include <cmath>
namespace cg = cooperative_groups;

#define LAS __attribute__((address_space(3)))
#define HD __host__ __device__ __forceinline__
#define DI __device__ __forceinline__
typedef unsigned short bf16_t;
typedef short bf16x8 __attribute__((ext_vector_type(8)));
typedef float f32x4 __attribute__((ext_vector_type(4)));
typedef float f32x2 __attribute__((ext_vector_type(2)));
typedef unsigned u32x4 __attribute__((ext_vector_type(4)));
typedef unsigned u32x2 __attribute__((ext_vector_type(2)));

constexpr int D = 1024, NB = 2, SEQ = 16384, CTX = 256, RB = CTX + SEQ, RT = NB * RB;
constexpr int NIN = 7936, DFF = 2816;
constexpr int NBLK = RB / 64;
constexpr int FM = 16384;
constexpr int NT = 512;
constexpr int LDS_BYTES = 155648;
#ifndef PMASK
#define PMASK 0xFFFFFFFFu
#endif
#define PON(k) ((PMASK >> (k)) & 1u)
#ifndef PROBE
#define PROBE 0
#endif
#define RPT(p) for (int rp_ = 0; rp_ < (PROBE == (p) ? 2 : 1); ++rp_)

enum { I_X = 0, I_C, I_CTX, I_CCTX, I_ADAW, I_ADAB, I_N1G, I_WIN, I_WA2, I_BA, I_SHW, I_SHB, I_HW1, I_HB1, I_HW2, I_HB2, I_HW3, I_HFREQ, I_HBIAS,
       I_WBR, I_WOUT, I_N2G, I_WUP, I_FCW, I_FCB, I_WDN, I_FING, N_INPUTS };

struct Params { const float* in[N_INPUTS]; float* out; unsigned char* ws; };


typedef const Params __attribute__((address_space(4)))* PP4;
DI PP4 getP() { PP4 p = (PP4)__builtin_amdgcn_kernarg_segment_ptr(); asm volatile("" : "+s"(p)); return p; }
DI int otid() { int t = threadIdx.x; asm volatile("" : "+v"(t)); return t; }
DI int obid() { int t = blockIdx.x; asm volatile("" : "+s"(t)); return t; }
DI int ogrid() { int t = gridDim.x; asm volatile("" : "+s"(t)); return t; }

constexpr size_t al256(size_t x) { return (x + 255) & ~(size_t)255; }
constexpr size_t O_BAR = 0;
constexpr size_t BAR_BYTES = 16384;
constexpr size_t O_MOD = BAR_BYTES;
constexpr size_t O_XCTX = al256(O_MOD + (size_t)2 * 3 * 6144 * 4);
constexpr size_t O_HDN = al256(O_XCTX + (size_t)2 * 256 * 1024 * 4);
constexpr size_t O_HFC = al256(O_HDN + (size_t)16640 * 64 * 4);
constexpr size_t O_ABUF = al256(O_HFC + (size_t)2 * 256 * 512 * 4);
constexpr size_t O_LR = al256(O_ABUF + (size_t)16 * 260 * 64 * 4);
constexpr size_t O_ZCTX = al256(O_LR + (size_t)16640 * 32 * 4);
constexpr size_t O_WT = al256(O_ZCTX + (size_t)256 * 512 * 4);
constexpr size_t WT_IN = 0, WT_BR = WT_IN + (size_t)NIN * 1024, WT_OUT = WT_BR + (size_t)3 * 1024 * 512, WT_UP = WT_OUT + (size_t)1024 * 1024,
                 WT_DN = WT_UP + (size_t)5632 * 1024, WT_END = WT_DN + (size_t)1024 * 2816;
constexpr size_t O_BIG = al256(O_WT + WT_END * 2);
constexpr size_t O_K = O_BIG;
constexpr size_t O_H = al256(O_K + (size_t)512 * 16384 * 8);
constexpr size_t O_PRET = al256(O_H + (size_t)RB * 1024 * 2);
constexpr size_t O_PGLA = al256(O_PRET + (size_t)RB * 1536 * 2);
constexpr size_t O_PHY = al256(O_PGLA + (size_t)RB * 1536 * 2);
constexpr size_t O_GATES = al256(O_PHY + (size_t)RB * 1536 * 2);
constexpr size_t O_U = al256(O_GATES + (size_t)RB * 3072 * 2);
constexpr size_t O_ZT = al256(O_U + (size_t)16 * 260 * 8192 * 2);
constexpr size_t O_X0C = al256(O_ZT + (size_t)512 * 16384 * 2);
constexpr size_t O_MIX_END = al256(O_X0C + (size_t)RB * 512 * 2);
constexpr size_t O_H2 = O_BIG;
constexpr size_t O_A = al256(O_H2 + (size_t)RT * 1024 * 2);
constexpr size_t O_V = al256(O_A + (size_t)RT * DFF * 2);
constexpr size_t O_FFN_END = al256(O_V + (size_t)RT * DFF * 2);
constexpr size_t WS_NEED = O_MIX_END > O_FFN_END ? O_MIX_END : O_FFN_END;
static_assert(WS_NEED <= (size_t)512 * 1024 * 1024, "workspace over 512 MiB");

HD float bf2f(bf16_t v) { union { unsigned u; float f; } c; c.u = ((unsigned)v) << 16; return c.f; }
HD unsigned pk2(float lo, float hi) {
#if defined(__HIP_DEVICE_COMPILE__)
    unsigned r; asm volatile("v_cvt_pk_bf16_f32 %0, %1, %2" : "=v"(r) : "v"(lo), "v"(hi)); return r;
#else
    union { unsigned u; float f; } a, b; a.f = lo; b.f = hi; unsigned x = a.u, y = b.u; x += 0x7FFFu + ((x >> 16) & 1u); y += 0x7FFFu + ((y >> 16) & 1u); return (x >> 16) | (y & 0xffff0000u);
#endif
}
HD bf16_t f2bf(float f) { return (bf16_t)(pk2(f, 0.f) & 0xffffu); }
DI float wave_sum(float v) {
#pragma unroll
    for (int o = 1; o < 64; o <<= 1) v += __shfl_xor(v, o);
    return v;
}
DI float silu_f(float x) { return x * __builtin_amdgcn_rcpf(1.0f + __expf(-x)); }
DI float sigmoid_f(float x) { return __builtin_amdgcn_rcpf(1.0f + __expf(-x)); }


#define XB_TMO      128
#define XB_XCNT(j)  (256  + 64 * (j))
#define XB_XSUB(j)  (1280 + 64 * (j))
#define XB_XGEN(j)  (2304 + 64 * (j))
#define XB_TOP      3328
#define XB_TOPGEN   3392
#define XCD_BAR_WORDS 3456
#define XB_SPIN_CAP (1u << 20)
DI unsigned xb_ld(unsigned* p) { return __hip_atomic_load(p, __ATOMIC_RELAXED, __HIP_MEMORY_SCOPE_AGENT); }
DI unsigned xb_add(unsigned* p, unsigned v) { return __hip_atomic_fetch_add(p, v, __ATOMIC_RELAXED, __HIP_MEMORY_SCOPE_AGENT); }
DI unsigned xb_xcc_id() { return (unsigned)__builtin_amdgcn_s_getreg((3 << 11) | 20) & 0xFu; }
#define XB_SPIN(cond, bar) do { unsigned _sp = 0; while (cond) { __builtin_amdgcn_s_sleep(1); \
    if ((++_sp & 255u) == 0u) { if (xb_ld(&(bar)[XB_TMO])) break; if (_sp > XB_SPIN_CAP) { atomicAdd(&(bar)[XB_TMO], 1u); break; } } } } while (0)
struct XcdBarrier { unsigned* bar; unsigned x; volatile LAS unsigned* st; };
DI XcdBarrier xcd_barrier_post(unsigned* bar, volatile LAS unsigned* st) {
    XcdBarrier b; b.bar = bar; b.x = xb_xcc_id(); b.st = st;
    if (threadIdx.x == 0) (void)xb_add(&bar[XB_XCNT(b.x)], 1u);
    return b;
}
DI void xcd_barrier_complete(unsigned* bar, unsigned x, unsigned& nloc, unsigned& nx) {
    const unsigned G = gridDim.x * gridDim.y * gridDim.z;
    unsigned sum, cnt, mine, sp = 0u;
    for (;;) {
        sum = 0u; cnt = 0u; mine = 0u;
#pragma unroll
        for (unsigned j = 0; j < 16; ++j) { const unsigned c = xb_ld(&bar[XB_XCNT(j)]); sum += c; cnt += (c > 0u) ? 1u : 0u; mine = (j == x) ? c : mine; }
        if (sum == G) break;
        __builtin_amdgcn_s_sleep(1);
        if ((++sp & 255u) == 0u) { if (xb_ld(&bar[XB_TMO])) break; if (sp > XB_SPIN_CAP) { atomicAdd(&bar[XB_TMO], 1u); break; } }
    }
    nloc = mine > 0u ? mine : 1u; nx = cnt > 0u ? cnt : 1u;
}
DI void xcd_barrier(const XcdBarrier& b) {
    asm volatile("s_waitcnt vmcnt(0)" ::: "memory");
    __syncthreads();
    if (threadIdx.x == 0) {
        unsigned* bar = b.bar;
        __builtin_amdgcn_s_waitcnt(0);
        unsigned nloc = b.st[0], nx = b.st[1];
        if (nloc == 0u) { xcd_barrier_complete(bar, b.x, nloc, nx); b.st[0] = nloc; b.st[1] = nx; }
        const unsigned old = xb_add(&bar[XB_XSUB(b.x)], 1u);
        const unsigned gen = old / nloc;
        if (old + 1u == (gen + 1u) * nloc) {
            __builtin_amdgcn_fence(__ATOMIC_RELEASE, "agent");
            asm volatile("s_waitcnt vmcnt(0)" ::: "memory");
            const unsigned og = xb_add(&bar[XB_TOP], 1u);
            const unsigned tg = og / nx;
            if (og + 1u == (tg + 1u) * nx) xb_add(&bar[XB_TOPGEN], 1u);
            else XB_SPIN(xb_ld(&bar[XB_TOPGEN]) == tg, bar);
            __builtin_amdgcn_fence(__ATOMIC_ACQUIRE, "agent");
            xb_add(&bar[XB_XGEN(b.x)], 1u);
            asm volatile("s_waitcnt vmcnt(0)" ::: "memory");
        } else {
            XB_SPIN(xb_ld(&bar[XB_XGEN(b.x)]) == gen, bar);
            __builtin_amdgcn_fence(__ATOMIC_ACQUIRE, "agent");
            asm volatile("s_waitcnt vmcnt(0)" ::: "memory");
        }
    }
    __syncthreads();
}

namespace pg8 {
constexpr int BM = 256, BK = 64, HALF = 128, HTB = HALF * BK * 2, STAGE_BYTES = 8 * HTB, NXCD = 8, WGM = 4;
HD int lds_byte(int r, int c) { const int st = (r >> 4) * 2 + (c >> 5), rr = r & 15, cc = c & 31, ob = rr * 64 + cc * 2; return st * 1024 + (ob ^ (((ob >> 9) & 1) << 5)); }
HD void stage_rc(int b, int& R, int& C) { const int st = b / 1024, sb = b % 1024, swz = sb ^ (((sb >> 9) & 1) << 5); R = (st >> 1) * 16 + swz / 64; C = (st & 1) * 32 + (swz % 64) / 2; }
HD int perm32(int rho) { const int n = rho >> 4, i = rho & 15; return 8 * (i >> 2) + 4 * n + (i & 3); }

struct Unit { int pm, pn, rep; };
struct Gemm { const bf16_t* A; const bf16_t* Bt; int lda, ldb, K; long arep, brep; };
struct Sched {
    int nM, nN, nwg, G, c, pm0, nrep, jmode;
    DI void init(int nM_, int nN_, int G_, int c_, int pm0_, int nrep_, int jmode_ = 0) { nM = nM_; nN = nN_; nwg = nM * nN; G = G_; c = c_; pm0 = pm0_; nrep = nrep_; jmode = jmode_; }
    DI bool next(int i, Unit& u) const {
        int it = i, rep = 0;
        if (nrep == 3) { it = i / 3; rep = i - it * 3; }
        const long L = (long)it * G + c; if (L >= nwg) return false;
        int wgid = (int)L; { const int q = nwg / NXCD, r = nwg % NXCD, xcd = wgid % NXCD, off = wgid / NXCD; wgid = (xcd < r ? xcd * (q + 1) : r * (q + 1) + (xcd - r) * q) + off; }
        const int nig = WGM * nN, gid = wgid / nig, fm = gid * WGM, gsz = (nM - fm) < WGM ? (nM - fm) : WGM;
        int pm = fm + ((wgid % nig) % gsz); if (jmode) pm += 1 + (pm >= 64 ? 1 : 0);
        u.pm = pm0 + pm; u.pn = (wgid % nig) / gsz; u.rep = rep; return true;
    }
};
DI unsigned cvt_pk_bf16(float lo, float hi) { unsigned r; asm volatile("v_cvt_pk_bf16_f32 %0, %1, %2" : "=v"(r) : "v"(lo), "v"(hi)); return r; }

template <class Epi>
DI void gemm_phase(LAS unsigned char* lds, const Gemm g, const Sched& S, const Epi& E) {
    const int tid = otid(), wid = __builtin_amdgcn_readfirstlane(tid >> 6), lane = tid & 63, wr = wid >> 2, wc = wid & 3, fr = lane & 15, fq = lane >> 4;
    const int K = g.K, nt = K / BK;
    unsigned voffA[2], voffB[2];
#pragma unroll
    for (int i = 0; i < 2; ++i) { int R, C; stage_rc(tid * 16 + i * 8192, R, C); const int Rb = Epi::PERM ? ((R & ~31) + perm32(R & 31)) : R;
        voffA[i] = (unsigned)(R * g.lda + C) * 2u; voffB[i] = (unsigned)(Rb * g.ldb + C) * 2u; }
    const size_t kstep = (size_t)(BK * 2);
    const size_t hstepA = (size_t)HALF * g.lda * 2, hstepB = (size_t)HALF * g.ldb * 2;
    const size_t tstepA = 2 * hstepA, tstepB = 2 * hstepB;
    const unsigned ldsw = (unsigned)wid * 1024u;
    const int aoff = lds_byte(wr * 64 + fr, fq * 8), boff = lds_byte(wc * 32 + fr, fq * 8);
#define PG8_SA(b, h) (((b) * 2 + (h)) * HTB)
#define PG8_SB(b, h) ((4 + (b) * 2 + (h)) * HTB)
#define PG8_STAGE(bufoff, gbase, voff) do { _Pragma("unroll") for (int _i = 0; _i < 2; ++_i) \
        __builtin_amdgcn_global_load_lds((const unsigned*)((const char*)(gbase) + (voff)[_i]), (LAS unsigned*)(lds + (bufoff) + ldsw + _i * 8192), 16, 0, 0); } while (0)
#define PG8_LDA(dst, b, h) do { _Pragma("unroll") for (int m = 0; m < 4; ++m) _Pragma("unroll") for (int k = 0; k < 2; ++k) dst[m][k] = *(const LAS bf16x8*)(lds + PG8_SA(b, h) + aoff + m * 2048 + k * 1024); } while (0)
#define PG8_LDB(dst, b, h) do { _Pragma("unroll") for (int n = 0; n < 2; ++n) _Pragma("unroll") for (int k = 0; k < 2; ++k) dst[n][k] = *(const LAS bf16x8*)(lds + PG8_SB(b, h) + boff + n * 2048 + k * 1024); } while (0)
#define PG8_MMA(ai, bj, At, Bt) do { __builtin_amdgcn_s_setprio(1); _Pragma("unroll") for (int m = 0; m < 4; ++m) _Pragma("unroll") for (int n = 0; n < 2; ++n) _Pragma("unroll") for (int k = 0; k < 2; ++k) \
        acc[ai][bj][m][n] = __builtin_amdgcn_mfma_f32_16x16x32_bf16(Bt[n][k], At[m][k], acc[ai][bj][m][n], 0, 0, 0); __builtin_amdgcn_s_setprio(0); } while (0)
#define PG8_WAIT_V(n) asm volatile("s_waitcnt vmcnt(" #n ")" ::: "memory")
#define PG8_WAIT_L(n) asm volatile("s_waitcnt lgkmcnt(" #n ")" ::: "memory")
#define PG8_BAR __builtin_amdgcn_s_barrier()
#define PG8_SCHED __builtin_amdgcn_sched_barrier(0)
    Unit cur, nxt; int ui = 0;
    if (!S.next(0, cur)) return;
    f32x4 acc[2][2][4][2];
#pragma unroll
    for (int a = 0; a < 2; ++a)
#pragma unroll
        for (int b = 0; b < 2; ++b)
#pragma unroll
            for (int m = 0; m < 4; ++m)
#pragma unroll
                for (int n = 0; n < 2; ++n) acc[a][b][m][n] = (f32x4){0.f, 0.f, 0.f, 0.f};
    bf16x8 At[4][2], B0[2][2], B1[2][2];
    const char* cA = (const char*)g.A + (size_t)cur.pm * tstepA + (size_t)cur.rep * g.arep * 2;
    const char* cB = (const char*)g.Bt + (size_t)cur.pn * tstepB + (size_t)cur.rep * g.brep * 2;
    PG8_STAGE(PG8_SB(0, 0), cB, voffB); PG8_STAGE(PG8_SB(0, 1), cB + hstepB, voffB); PG8_STAGE(PG8_SA(0, 0), cA, voffA); PG8_STAGE(PG8_SA(0, 1), cA + hstepA, voffA);
    if (wr == 1) PG8_BAR;
    PG8_WAIT_V(2); PG8_BAR;
    PG8_STAGE(PG8_SB(1, 0), cB + kstep, voffB); PG8_STAGE(PG8_SA(1, 0), cA + kstep, voffA); PG8_STAGE(PG8_SB(1, 1), cB + hstepB + kstep, voffB);
    PG8_WAIT_V(6); PG8_BAR;
    for (;;) {
        const bool has_next = S.next(ui + 1, nxt);
        const char* nA = has_next ? (const char*)g.A + (size_t)nxt.pm * tstepA + (size_t)nxt.rep * g.arep * 2 : cA;
        const char* nB = has_next ? (const char*)g.Bt + (size_t)nxt.pn * tstepB + (size_t)nxt.rep * g.brep * 2 : cB;
        for (int t = 0; t < nt; t += 2) {
            const bool last = (t == nt - 2);
            const char* a1 = cA + (size_t)(t + 1) * kstep;
            const char* a2 = last ? nA : cA + (size_t)(t + 2) * kstep; const char* b2 = last ? nB : cB + (size_t)(t + 2) * kstep;
            const char* a3 = a2 + kstep; const char* b3 = b2 + kstep;
            PG8_LDB(B0, 0, 0); PG8_LDB(B1, 0, 1); PG8_SCHED; PG8_LDA(At, 0, 0); PG8_STAGE(PG8_SA(1, 1), a1 + hstepA, voffA);
            PG8_WAIT_V(8); PG8_WAIT_L(0); PG8_BAR; PG8_MMA(0, 0, At, B0); PG8_MMA(0, 1, At, B1); PG8_BAR; PG8_SCHED;
            PG8_LDA(At, 0, 1); PG8_STAGE(PG8_SB(0, 0), b2, voffB); PG8_STAGE(PG8_SB(0, 1), b2 + hstepB, voffB); PG8_STAGE(PG8_SA(0, 0), a2, voffA);
            PG8_WAIT_V(8); PG8_WAIT_L(0); PG8_BAR; PG8_MMA(1, 0, At, B0); PG8_MMA(1, 1, At, B1); PG8_BAR; PG8_SCHED;
            PG8_LDB(B0, 1, 0); PG8_LDB(B1, 1, 1); PG8_SCHED; PG8_LDA(At, 1, 0); PG8_STAGE(PG8_SA(0, 1), a2 + hstepA, voffA);
            PG8_WAIT_V(8); PG8_WAIT_L(0); PG8_BAR; PG8_MMA(0, 0, At, B0); PG8_MMA(0, 1, At, B1); PG8_BAR; PG8_SCHED;
            PG8_LDA(At, 1, 1); PG8_STAGE(PG8_SB(1, 0), b3, voffB); PG8_STAGE(PG8_SB(1, 1), b3 + hstepB, voffB); PG8_STAGE(PG8_SA(1, 0), a3, voffA);
            PG8_WAIT_V(8); PG8_WAIT_L(0); PG8_BAR; PG8_MMA(1, 0, At, B0); PG8_MMA(1, 1, At, B1); PG8_BAR; PG8_SCHED;
        }
        if (wr == 0) PG8_BAR;
        E(acc, cur, wr, wc, fr, fq);
        if (!has_next) break;
#pragma unroll
        for (int a = 0; a < 2; ++a)
#pragma unroll
            for (int b = 0; b < 2; ++b)
#pragma unroll
                for (int m = 0; m < 4; ++m)
#pragma unroll
                    for (int n = 0; n < 2; ++n) acc[a][b][m][n] = (f32x4){0.f, 0.f, 0.f, 0.f};
        cur = nxt; cA = nA; cB = nB; ++ui;
        if (wr == 1) PG8_BAR;
    }
    PG8_WAIT_V(0);
    PG8_BAR;
#undef PG8_SA
#undef PG8_SB
#undef PG8_STAGE
#undef PG8_LDA
#undef PG8_LDB
#undef PG8_MMA
#undef PG8_WAIT_V
#undef PG8_WAIT_L
#undef PG8_BAR
#undef PG8_SCHED
}

struct EpiWin {
    static constexpr bool PERM = true;
    bf16_t *pret, *pgla, *phy, *gates; float* lr;
    DI void operator()(const f32x4 (&acc)[2][2][4][2], const Unit& u, int wr, int wc, int fr, int fq) const {
        const int row0 = u.pm * BM + wr * 64 + fr; const int pn = u.pn;
        if (pn < 30) {
            bf16_t* base; int ldc, colt; bool sig = false;
            if (pn < 6) { base = pret; ldc = 1536; colt = pn * 256; }
            else if (pn < 12) { base = pgla; ldc = 1536; colt = (pn - 6) * 256; }
            else if (pn < 18) { base = phy; ldc = 1536; colt = (pn - 12) * 256; }
            else { base = gates; ldc = 3072; colt = (pn - 18) * 256; sig = true; }
            const int col0 = colt + wc * 32 + 8 * fq;
#pragma unroll
            for (int ai = 0; ai < 2; ++ai)
#pragma unroll
                for (int m = 0; m < 4; ++m) { bf16_t* rowp = base + (size_t)(row0 + ai * HALF + m * 16) * ldc + col0;
#pragma unroll
                    for (int bj = 0; bj < 2; ++bj) { f32x4 v0 = acc[ai][bj][m][0], v1 = acc[ai][bj][m][1];
                        if (sig) {
#pragma unroll
                            for (int j = 0; j < 4; ++j) { v0[j] = sigmoid_f(v0[j]); v1[j] = sigmoid_f(v1[j]); } }
                        u32x4 w; w.x = cvt_pk_bf16(v0[0], v0[1]); w.y = cvt_pk_bf16(v0[2], v0[3]); w.z = cvt_pk_bf16(v1[0], v1[1]); w.w = cvt_pk_bf16(v1[2], v1[3]);
                        __builtin_nontemporal_store(w, (u32x4*)(rowp + bj * HALF)); } }
        } else if (wc == 0) {
#pragma unroll
            for (int ai = 0; ai < 2; ++ai)
#pragma unroll
                for (int m = 0; m < 4; ++m) { float* rowp = lr + (size_t)(row0 + ai * HALF + m * 16) * 32 + 8 * fq;
                    *(f32x4*)(rowp) = acc[ai][0][m][0]; *(f32x4*)(rowp + 4) = acc[ai][0][m][1]; }
        }
    }
};
struct EpiUp {
    static constexpr bool PERM = true;
    bf16_t *a, *v;
    DI void operator()(const f32x4 (&acc)[2][2][4][2], const Unit& u, int wr, int wc, int fr, int fq) const {
        const int row0 = u.pm * BM + wr * 64 + fr;
        bf16_t* base = u.pn < 11 ? a : v; const int colt = (u.pn < 11 ? u.pn : u.pn - 11) * 256;
        const int col0 = colt + wc * 32 + 8 * fq;
#pragma unroll
        for (int ai = 0; ai < 2; ++ai)
#pragma unroll
            for (int m = 0; m < 4; ++m) { bf16_t* rowp = base + (size_t)(row0 + ai * HALF + m * 16) * DFF + col0;
#pragma unroll
                for (int bj = 0; bj < 2; ++bj) { const f32x4 v0 = acc[ai][bj][m][0], v1 = acc[ai][bj][m][1];
                    u32x4 w; w.x = cvt_pk_bf16(v0[0], v0[1]); w.y = cvt_pk_bf16(v0[2], v0[3]); w.z = cvt_pk_bf16(v1[0], v1[1]); w.w = cvt_pk_bf16(v1[2], v1[3]);
                    __builtin_nontemporal_store(w, (u32x4*)(rowp + bj * HALF)); } }
    }
};
struct EpiMerge {
    static constexpr bool PERM = true;
    const bf16_t* gates; bf16_t* mixed;
    DI void operator()(const f32x4 (&acc)[2][2][4][2], const Unit& u, int wr, int wc, int fr, int fq) const {
        const int row0 = u.pm * BM + wr * 64 + fr; const int col0 = u.pn * 256 + wc * 32 + 8 * fq;
#pragma unroll
        for (int ai = 0; ai < 2; ++ai)
#pragma unroll
            for (int m = 0; m < 4; ++m) { const size_t row = (size_t)(row0 + ai * HALF + m * 16);
#pragma unroll
                for (int bj = 0; bj < 2; ++bj) {
                    const u32x4 gv = *(const u32x4*)(gates + row * 3072 + u.rep * 1024 + col0 + bj * HALF);
                    bf16_t* mp = mixed + row * 1024 + col0 + bj * HALF;
                    u32x4 pv = (u32x4){0u, 0u, 0u, 0u}; if (u.rep > 0) pv = *(const u32x4*)mp;
                    const f32x4 v0 = acc[ai][bj][m][0], v1 = acc[ai][bj][m][1];
                    float o[8];
#pragma unroll
                    for (int j = 0; j < 4; ++j) { const unsigned gw = gv[j], pw = pv[j]; const float a0 = (j < 2) ? v0[2 * j] : v1[2 * j - 4], a1 = (j < 2) ? v0[2 * j + 1] : v1[2 * j - 3];
                        o[2 * j] = __uint_as_float(pw << 16) + __uint_as_float(gw << 16) * a0; o[2 * j + 1] = __uint_as_float(pw & 0xffff0000u) + __uint_as_float(gw & 0xffff0000u) * a1; }
                    u32x4 w; w.x = cvt_pk_bf16(o[0], o[1]); w.y = cvt_pk_bf16(o[2], o[3]); w.z = cvt_pk_bf16(o[4], o[5]); w.w = cvt_pk_bf16(o[6], o[7]);
                    *(u32x4*)mp = w; } }
    }
};
struct EpiRes {
    static constexpr bool PERM = false;
    const float* src_lat; float* dst_lat; const float* src_ctx; float* dst_ctx; const float* mod; int goff; int rowbase;
    DI void operator()(const f32x4 (&acc)[2][2][4][2], const Unit& u, int wr, int wc, int fr, int fq) const {
        const int R0 = rowbase + u.pm * BM; const int b = R0 / RB; const int rr0 = R0 - b * RB; const bool isctx = rr0 < CTX;
        const float* sp = isctx ? src_ctx + (size_t)b * CTX * D : src_lat + (size_t)b * SEQ * D;
        float* dp = isctx ? dst_ctx + (size_t)b * CTX * D : dst_lat + (size_t)b * SEQ * D;
        const int lr0 = (isctx ? rr0 : rr0 - CTX) + wr * 64 + fr; const int col0 = u.pn * BM + wc * 32 + 4 * fq;
        const float* gp = mod + (isctx ? 2 : b) * 6144 + goff + col0;
        f32x4 gv[2][2];
#pragma unroll
        for (int bj = 0; bj < 2; ++bj)
#pragma unroll
            for (int n = 0; n < 2; ++n) gv[bj][n] = *(const f32x4*)(gp + bj * HALF + n * 16);
#pragma unroll
        for (int ai = 0; ai < 2; ++ai)
#pragma unroll
            for (int m = 0; m < 4; ++m) { const size_t off = (size_t)(lr0 + ai * HALF + m * 16) * D + col0;
#pragma unroll
                for (int bj = 0; bj < 2; ++bj)
#pragma unroll
                    for (int n = 0; n < 2; ++n) { const f32x4 xs = *(const f32x4*)(sp + off + bj * HALF + n * 16);
                        *(f32x4*)(dp + off + bj * HALF + n * 16) = xs + gv[bj][n] * acc[ai][bj][m][n]; }
                asm volatile("" ::: "memory"); }
    }
};
}

typedef float cf __attribute__((ext_vector_type(2)));
HD cf cmul(cf a, cf b) { const cf bs = {-b.y, b.x}; return a.xx * b + a.yy * bs; }
HD cf cadd(cf a, cf b) { return a + b; }
HD cf csub(cf a, cf b) { return a - b; }
HD cf cconj(cf a) { cf r; r.x = a.x; r.y = -a.y; return r; }
HD void sincos_turns(float fr, float& s, float& c) {
#if defined(__HIP_DEVICE_COMPILE__)
    s = __builtin_amdgcn_sinf(fr); c = __builtin_amdgcn_cosf(fr);
#else
    s = (float)sin(6.283185307179586 * (double)fr); c = (float)cos(6.283185307179586 * (double)fr);
#endif
}
HD int rev4_14(int x) {
#if defined(__HIP_DEVICE_COMPILE__)
    unsigned v = __builtin_bitreverse32((unsigned)x) >> 18;
#else
    unsigned v = (unsigned)x;
    v = ((v >> 1) & 0x55555555u) | ((v & 0x55555555u) << 1); v = ((v >> 2) & 0x33333333u) | ((v & 0x33333333u) << 2); v = ((v >> 4) & 0x0F0F0F0Fu) | ((v & 0x0F0F0F0Fu) << 4);
    v = ((v >> 8) & 0x00FF00FFu) | ((v & 0x00FF00FFu) << 8); v = (v >> 16) | (v << 16);
    v >>= 18;
#endif
    return (int)(((v & 0x1555u) << 1) | ((v >> 1) & 0x1555u));
}
HD void bfly_fwd(cf& a0, cf& a1, cf& a2, cf& a3) {
    const cf t0 = a0 + a2, t1 = a0 - a2, t2 = a1 + a3, t3 = a1 - a3; const cf r = {t3.y, -t3.x};
    a0 = t0 + t2; a2 = t0 - t2; a1 = t1 + r; a3 = t1 - r;
}
HD void bfly_inv(cf& a0, cf& a1, cf& a2, cf& a3) {
    const cf t0 = a0 + a2, t1 = a0 - a2, t2 = a1 + a3, t3 = a1 - a3; const cf r = {t3.y, -t3.x};
    a0 = t0 + t2; a2 = t0 - t2; a1 = t1 - r; a3 = t1 + r;
}
HD int PX(int p) { return p + (p >> 4); }
constexpr int FMP = FM + FM / 16;
template <class P> HD void fft_fwd_stage(P x, int s, int tid, int nth) {
    const int lgq = 12 - 2 * s, q = 1 << lgq, n = q * 4;
#pragma unroll 4
    for (int b = tid; b < 4096; b += nth) {
        const int blk = b >> lgq, j = b & (q - 1), base = blk * n + j;
        cf a0 = x[PX(base)], a1 = x[PX(base + q)], a2 = x[PX(base + 2 * q)], a3 = x[PX(base + 3 * q)];
        bfly_fwd(a0, a1, a2, a3);
        float sn, cs; sincos_turns((float)(j << (2 * s)) * (1.0f / 16384.0f), sn, cs);
        cf w; w.x = cs; w.y = -sn; const cf w2 = cmul(w, w), w3 = cmul(w2, w);
        x[PX(base)] = a0; x[PX(base + q)] = cmul(a1, w); x[PX(base + 2 * q)] = cmul(a2, w2); x[PX(base + 3 * q)] = cmul(a3, w3);
    }
}
template <class P> HD void fft_inv_stage(P x, int s, int tid, int nth) {
    const int lgq = 12 - 2 * s, q = 1 << lgq, n = q * 4;
#pragma unroll 4
    for (int b = tid; b < 4096; b += nth) {
        const int blk = b >> lgq, j = b & (q - 1), base = blk * n + j;
        float sn, cs; sincos_turns((float)(j << (2 * s)) * (1.0f / 16384.0f), sn, cs);
        cf w; w.x = cs; w.y = sn; const cf w2 = cmul(w, w), w3 = cmul(w2, w);
        cf b0 = x[PX(base)], b1 = cmul(x[PX(base + q)], w), b2 = cmul(x[PX(base + 2 * q)], w2), b3 = cmul(x[PX(base + 3 * q)], w3);
        bfly_inv(b0, b1, b2, b3);
        x[PX(base)] = b0; x[PX(base + q)] = b1; x[PX(base + 2 * q)] = b2; x[PX(base + 3 * q)] = b3;
    }
}
HD cf tw16(int k) {
    const float c1 = 0.92387953251128674f, s1 = 0.38268343236508977f, c2 = 0.70710678118654752f;
    cf r;
    switch (k) { case 0: r.x = 1.f; r.y = 0.f; break; case 1: r.x = c1; r.y = -s1; break; case 2: r.x = c2; r.y = -c2; break; case 3: r.x = s1; r.y = -c1; break;
                 case 4: r.x = 0.f; r.y = -1.f; break; case 6: r.x = -c2; r.y = -c2; break; case 9: r.x = -c1; r.y = s1; break; default: r.x = 0.f; r.y = 0.f; break; }
    return r;
}
template <class P> HD void fft_fwd_pair(P x, int s, int tid, int nth) {
    const int lgq4 = 10 - 2 * s, q4 = 1 << lgq4;
    for (int gidx = tid; gidx < 1024; gidx += nth) {
        const int blk = gidx >> lgq4, jp = gidx & (q4 - 1), base = (blk << (lgq4 + 4)) + jp;
        cf v[16];
#pragma unroll
        for (int i = 0; i < 16; ++i) v[i] = x[PX(base + (i << lgq4))];
        float sn0, cs0; sincos_turns((float)(jp << (2 * s)) * (1.0f / 16384.0f), sn0, cs0);
        cf wb; wb.x = cs0; wb.y = -sn0; const cf wb2 = cmul(wb, wb);
#pragma unroll
        for (int il = 0; il < 4; ++il) { bfly_fwd(v[il], v[il + 4], v[il + 8], v[il + 12]);
            const cf w = il == 0 ? wb : cmul(wb, tw16(il)); const cf w2 = il == 0 ? wb2 : cmul(w, w), w3 = cmul(w2, w);
            v[il + 4] = cmul(v[il + 4], w); v[il + 8] = cmul(v[il + 8], w2); v[il + 12] = cmul(v[il + 12], w3); }
        { const cf w = cmul(wb2, wb2); const cf w2 = cmul(w, w), w3 = cmul(w2, w);
#pragma unroll
          for (int r = 0; r < 4; ++r) { bfly_fwd(v[4 * r], v[4 * r + 1], v[4 * r + 2], v[4 * r + 3]);
              v[4 * r + 1] = cmul(v[4 * r + 1], w); v[4 * r + 2] = cmul(v[4 * r + 2], w2); v[4 * r + 3] = cmul(v[4 * r + 3], w3); } }
#pragma unroll
        for (int i = 0; i < 16; ++i) x[PX(base + (i << lgq4))] = v[i];
    }
}
template <class P> HD void fft_inv_pair(P x, int s, int tid, int nth) {
    const int lgq4 = 10 - 2 * s, q4 = 1 << lgq4;
    for (int gidx = tid; gidx < 1024; gidx += nth) {
        const int blk = gidx >> lgq4, jp = gidx & (q4 - 1), base = (blk << (lgq4 + 4)) + jp;
        cf v[16];
#pragma unroll
        for (int i = 0; i < 16; ++i) v[i] = x[PX(base + (i << lgq4))];
        float sn0, cs0; sincos_turns((float)(jp << (2 * s)) * (1.0f / 16384.0f), sn0, cs0);
        cf wb; wb.x = cs0; wb.y = sn0; const cf wb2 = cmul(wb, wb);
        { const cf w = cmul(wb2, wb2); const cf w2 = cmul(w, w), w3 = cmul(w2, w);
#pragma unroll
          for (int r = 0; r < 4; ++r) { v[4 * r + 1] = cmul(v[4 * r + 1], w); v[4 * r + 2] = cmul(v[4 * r + 2], w2); v[4 * r + 3] = cmul(v[4 * r + 3], w3);
              bfly_inv(v[4 * r], v[4 * r + 1], v[4 * r + 2], v[4 * r + 3]); } }
#pragma unroll
        for (int il = 0; il < 4; ++il) {
            const cf w = il == 0 ? wb : cmul(wb, cconj(tw16(il))); const cf w2 = il == 0 ? wb2 : cmul(w, w), w3 = cmul(w2, w);
            v[il + 4] = cmul(v[il + 4], w); v[il + 8] = cmul(v[il + 8], w2); v[il + 12] = cmul(v[il + 12], w3);
            bfly_inv(v[il], v[il + 4], v[il + 8], v[il + 12]); }
#pragma unroll
        for (int i = 0; i < 16; ++i) x[PX(base + (i << lgq4))] = v[i];
    }
}
template <class P> HD void fft16_fwd(P x, int tid, int nth) {
    for (int blk = tid; blk < 1024; blk += nth) {
        cf v[16];
#pragma unroll
        for (int i = 0; i < 16; ++i) v[i] = x[PX(blk * 16 + i)];
#pragma unroll
        for (int j = 0; j < 4; ++j) { bfly_fwd(v[j], v[j + 4], v[j + 8], v[j + 12]);
            if (j > 0) { v[j + 4] = cmul(v[j + 4], tw16(j)); v[j + 8] = cmul(v[j + 8], tw16(2 * j)); v[j + 12] = cmul(v[j + 12], tw16(3 * j)); } }
#pragma unroll
        for (int b = 0; b < 4; ++b) bfly_fwd(v[4 * b], v[4 * b + 1], v[4 * b + 2], v[4 * b + 3]);
#pragma unroll
        for (int i = 0; i < 16; ++i) x[PX(blk * 16 + i)] = v[i];
    }
}
template <class P> HD void fft16_inv(P x, int tid, int nth) {
    for (int blk = tid; blk < 1024; blk += nth) {
        cf v[16];
#pragma unroll
        for (int i = 0; i < 16; ++i) v[i] = x[PX(blk * 16 + i)];
#pragma unroll
        for (int b = 0; b < 4; ++b) bfly_inv(v[4 * b], v[4 * b + 1], v[4 * b + 2], v[4 * b + 3]);
#pragma unroll
        for (int j = 0; j < 4; ++j) {
            if (j > 0) { v[j + 4] = cmul(v[j + 4], cconj(tw16(j))); v[j + 8] = cmul(v[j + 8], cconj(tw16(2 * j))); v[j + 12] = cmul(v[j + 12], cconj(tw16(3 * j))); }
            bfly_inv(v[j], v[j + 4], v[j + 8], v[j + 12]); }
#pragma unroll
        for (int i = 0; i < 16; ++i) x[PX(blk * 16 + i)] = v[i];
    }
}
template <class P> HD void filt_unpack(P x, cf* Kout, int tid, int nth) {
    for (int f = tid; f <= FM / 2; f += nth) {
        if (f == 0) { const cf a = x[PX(0)]; cf k; k.x = a.x + a.y; k.y = a.x - a.y; Kout[0] = k; continue; }
        const int g = FM - f; const cf A = x[PX(rev4_14(f))], B = x[PX(rev4_14(g))];
        cf E, O; E.x = 0.5f * (A.x + B.x); E.y = 0.5f * (A.y - B.y);
        O.x = 0.5f * (A.y + B.y); O.y = -0.5f * (A.x - B.x);
        float sn, cs; sincos_turns((float)f / (float)(2 * FM), sn, cs); cf w; w.x = cs; w.y = -sn;
        const cf T = cmul(w, O);
        Kout[f] = cadd(E, T); Kout[g] = cconj(csub(E, T));
    }
}
template <class P> HD void conv_pointwise(P x, const cf* K, int tid, int nth) {
    const float sc = 1.0f / (float)FM;
    for (int f0 = tid; f0 <= FM / 2; f0 += 8 * nth) {
        cf kfv[8], kgv[8];
#pragma unroll
        for (int i = 0; i < 8; ++i) { const int f = f0 + i * nth; if (f <= FM / 2) { kfv[i] = K[f]; kgv[i] = K[(FM - f) & (FM - 1)]; } }
#pragma unroll
        for (int i = 0; i < 8; ++i) { const int f = f0 + i * nth; if (f > FM / 2) continue;
            if (f == 0) { const cf a = x[PX(0)]; const cf k = kfv[i]; const float y0 = (a.x + a.y) * k.x, ym = (a.x - a.y) * k.y; cf r; r.x = 0.5f * (y0 + ym) * sc; r.y = 0.5f * (y0 - ym) * sc; x[PX(0)] = r; continue; }
            const int g = FM - f, pf = PX(rev4_14(f)), pg = PX(rev4_14(g)); const cf A = x[pf], B = x[pg];
            cf E, O; E.x = 0.5f * (A.x + B.x); E.y = 0.5f * (A.y - B.y); O.x = 0.5f * (A.y + B.y); O.y = -0.5f * (A.x - B.x);
            float sn, cs; sincos_turns((float)f * (1.0f / (float)(2 * FM)), sn, cs); cf w; w.x = cs; w.y = -sn;
            const cf T = cmul(w, O);
            const cf Xf = cadd(E, T), Xg = cconj(csub(E, T));
            const cf Yf = cmul(Xf, kfv[i]), Yg = cmul(Xg, kgv[i]);
            cf Pp, Qq; Pp.x = 0.5f * (Yf.x + Yg.x); Pp.y = 0.5f * (Yf.y - Yg.y);
            cf Dd; Dd.x = 0.5f * (Yf.x - Yg.x); Dd.y = 0.5f * (Yf.y + Yg.y);
            Qq = cmul(Dd, cconj(w));
            cf cfv, cgv; cfv.x = (Pp.x - Qq.y) * sc; cfv.y = (Pp.y + Qq.x) * sc;
            cgv.x = (Pp.x + Qq.y) * sc; cgv.y = (-Pp.y + Qq.x) * sc;
            x[pf] = cfv; x[pg] = cgv; }
    }
}

#if !defined(HOST_TEST)
DI void phase_adaln(PP4 P, LAS unsigned char* lds) {
    LAS float* sv = (LAS float*)lds;
    LAS float* red = sv + 3 * 1024;
    const int tid = otid(), wave = tid >> 6, lane = tid & 63;
    for (int i = tid; i < 3 * 1024; i += NT) { const int j = i >> 10, k = i & 1023; const float cvv = j < 2 ? P->in[I_C][j * 1024 + k] : P->in[I_CCTX][k]; sv[i] = silu_f(cvv); }
    __syncthreads();
    float* MOD = (float*)(P->ws + O_MOD);
    for (int item = obid(); item < 192; item += ogrid()) {
        const int l = item / 96, cgp = item % 96, n = cgp * 64 + lane;
        const float* W = P->in[I_ADAW] + (size_t)l * 1024 * 6144 + n;
        float a0 = 0.f, a1 = 0.f, a2 = 0.f;
#pragma unroll 16
        for (int kk = 0; kk < 128; ++kk) { const int k = wave * 128 + kk; const float w = W[(size_t)k * 6144]; a0 += sv[k] * w; a1 += sv[1024 + k] * w; a2 += sv[2048 + k] * w; }
        red[(wave * 3 + 0) * 64 + lane] = a0; red[(wave * 3 + 1) * 64 + lane] = a1; red[(wave * 3 + 2) * 64 + lane] = a2;
        __syncthreads();
        if (tid < 192) { const int j = tid >> 6, ln = tid & 63; float s = 0.f;
#pragma unroll
            for (int w = 0; w < 8; ++w) s += red[(w * 3 + j) * 64 + ln];
            MOD[((size_t)l * 3 + j) * 6144 + cgp * 64 + ln] = s + P->in[I_ADAB][(size_t)l * 6144 + cgp * 64 + ln]; }
        __syncthreads();
    }
}

DI int win_src_col(int n) {
    if (n < 3072) return n;
    if (n < 4608) return n + 32;
    if (n < 7680) return n + 32;
    if (n < 7712) return n - 7680 + 3072;
    return -1;
}
DI void wt_tile(const float* W, int K, int N, bf16_t* WT, int k0, int n0, int mode, LAS float* tile) {
    const int tid = otid();
    const int nn = tid & 127; const int nd = n0 + nn; const int sc = mode ? win_src_col(nd) : nd;
    float v[16];
#pragma unroll
    for (int i = 0; i < 16; ++i) { const int kk = (tid >> 7) + 4 * i; v[i] = sc >= 0 ? W[(size_t)(k0 + kk) * N + sc] : 0.f; }
#pragma unroll
    for (int i = 0; i < 16; ++i) { const int kk = (tid >> 7) + 4 * i; tile[kk * 129 + nn] = v[i]; }
    __syncthreads();
    { const int n = tid >> 2, k16 = (tid & 3) * 16; const LAS float* s = tile + k16 * 129 + n;
      u32x4 o0, o1;
      o0.x = pk2(s[0], s[129]); o0.y = pk2(s[2 * 129], s[3 * 129]); o0.z = pk2(s[4 * 129], s[5 * 129]); o0.w = pk2(s[6 * 129], s[7 * 129]);
      o1.x = pk2(s[8 * 129], s[9 * 129]); o1.y = pk2(s[10 * 129], s[11 * 129]); o1.z = pk2(s[12 * 129], s[13 * 129]); o1.w = pk2(s[14 * 129], s[15 * 129]);
      bf16_t* dst = WT + (size_t)(n0 + n) * K + k0 + k16; *(u32x4*)dst = o0; *(u32x4*)(dst + 8) = o1; }
    __syncthreads();
}
constexpr int WT_T_IN = 16 * (NIN / 128), WT_T_BR = WT_T_IN + 3 * 8 * 8, WT_T_OUT = WT_T_BR + 16 * 8, WT_T_UP = WT_T_OUT + 16 * 44, WT_T_DN = WT_T_UP + 44 * 8;
DI void phase_wconv(PP4 P, LAS unsigned char* lds, int l, int lo, int hi, int rank, int nranks) {
    LAS float* tile = (LAS float*)lds;
    bf16_t* WT = (bf16_t*)(P->ws + O_WT);
    constexpr int T_IN = 16 * (NIN / 128), T_BR = 3 * 8 * 8, T_OUT = 16 * 8, T_UP = 16 * 44, T_DN = 44 * 8, T_ALL = T_IN + T_BR + T_OUT + T_UP + T_DN;
    for (int it = lo + rank; it < hi && it < T_ALL; it += nranks) {
        int r = it;
        if (r < T_IN) { const int nb = r / 16, kb = r % 16; wt_tile(P->in[I_WIN] + (size_t)l * 1024 * 7712, 1024, 7712, WT + WT_IN, kb * 64, nb * 128, 1, tile); continue; } r -= T_IN;
        if (r < T_BR) { const int br = r / 64, r2 = r % 64, nb = r2 / 8, kb = r2 % 8; wt_tile(P->in[I_WBR] + ((size_t)l * 3 + br) * 512 * 1024, 512, 1024, WT + WT_BR + (size_t)br * 1024 * 512, kb * 64, nb * 128, 0, tile); continue; } r -= T_BR;
        if (r < T_OUT) { const int nb = r / 16, kb = r % 16; wt_tile(P->in[I_WOUT] + (size_t)l * 1024 * 1024, 1024, 1024, WT + WT_OUT, kb * 64, nb * 128, 0, tile); continue; } r -= T_OUT;
        if (r < T_UP) { const int nb = r / 16, kb = r % 16; wt_tile(P->in[I_WUP] + (size_t)l * 1024 * 5632, 1024, 5632, WT + WT_UP, kb * 64, nb * 128, 0, tile); continue; } r -= T_UP;
        { const int nb = r / 44, kb = r % 44; wt_tile(P->in[I_WDN] + (size_t)l * 2816 * 1024, 2816, 1024, WT + WT_DN, kb * 64, nb * 128, 0, tile); }
    }
}

DI float sin_fast(float x) { return __builtin_amdgcn_sinf(x * 0.15915494309189535f); }
DI void phase_filt1(PP4 P, LAS unsigned char* lds, int l, int rank, int nranks) {
    const int tid = otid(), wave = tid >> 6, lane = tid & 63;
    LAS float* feat = (LAS float*)lds + wave * 128;
    LAS float* hid = feat + 64;
    const float* w1 = P->in[I_HW1] + (size_t)l * 33 * 64; const float* w2 = P->in[I_HW2] + (size_t)l * 2 * 64 * 64;
    float w1r[33], w2a[64], w2b[64];
#pragma unroll
    for (int f = 0; f < 33; ++f) w1r[f] = w1[f * 64 + lane];
#pragma unroll
    for (int k = 0; k < 64; ++k) { w2a[k] = w2[k * 64 + lane]; w2b[k] = w2[4096 + k * 64 + lane]; }
    const float b1v = P->in[I_HB1][l * 64 + lane], b2a = P->in[I_HB2][l * 128 + lane], b2b = P->in[I_HB2][l * 128 + 64 + lane];
    const float fq = P->in[I_HFREQ][l * 64 + lane];
    float* HDN = (float*)(P->ws + O_HDN);
    for (int base = rank * 8; base < 16640; base += nranks * 8) {
        const int pos = base + wave; const int L = pos < 16384 ? 16384 : 256; const int i = pos < 16384 ? pos : pos - 16384;
        if (lane == 0) feat[0] = (float)i / (float)(L - 1);
        if (lane < 16) { const float band = 1e-4f + (float)lane * ((15.0f - 1e-4f) / 15.0f); const float turns = (float)i * band * (1.0f / (float)L);
            feat[1 + lane] = __builtin_amdgcn_cosf(turns); feat[17 + lane] = -__builtin_amdgcn_sinf(turns); }
        __syncthreads();
        float a = b1v;
#pragma unroll
        for (int f = 0; f < 33; ++f) a += feat[f] * w1r[f];
        float h = sin_fast(fq * a);
        hid[lane] = h;
        __syncthreads();
        float s0 = b2a;
#pragma unroll
        for (int k4 = 0; k4 < 16; ++k4) { const f32x4 hv = *(const LAS f32x4*)(hid + 4 * k4); s0 += hv[0] * w2a[4 * k4] + hv[1] * w2a[4 * k4 + 1] + hv[2] * w2a[4 * k4 + 2] + hv[3] * w2a[4 * k4 + 3]; }
        h = sin_fast(fq * s0);
        __syncthreads();
        hid[lane] = h;
        __syncthreads();
        float s1 = b2b;
#pragma unroll
        for (int k4 = 0; k4 < 16; ++k4) { const f32x4 hv = *(const LAS f32x4*)(hid + 4 * k4); s1 += hv[0] * w2b[4 * k4] + hv[1] * w2b[4 * k4 + 1] + hv[2] * w2b[4 * k4 + 2] + hv[3] * w2b[4 * k4 + 3]; }
        h = sin_fast(fq * s1);
        HDN[(size_t)pos * 64 + lane] = h;
        __syncthreads();
    }
}
DI float hy_window(int i, int L, int c) {
    const float mn = -3.0701134573253946f, mx = -15.350567286626973f;
    const float delta = fabsf(mn + (float)c * ((mx - mn) / 511.0f)); const float t = (float)i / (float)(L - 1);
    return expf(-t * delta) + 0.05f;
}
DI void phase_filt2(PP4 P, LAS unsigned char* lds, int l) {
    LAS float* hd = (LAS float*)lds;
    LAS float* wf = hd + 64 * 65;
    LAS float* wb = wf + 4096;
    LAS float* ot = wb + 4096;
    const int tid = otid(), wave = tid >> 6, lane = tid & 63;
    const float* HDN = (const float*)(P->ws + O_HDN); const float* w3 = P->in[I_HW3] + (size_t)l * 64 * 1024; const float* hb = P->in[I_HBIAS] + l * 512;
    float* KT = (float*)(P->ws + O_K); float* HFC = (float*)(P->ws + O_HFC);
    for (int item = obid(); item < 2080; item += ogrid()) {
        const int lt = item >> 3, ct = item & 7; const bool isctx = lt >= 256; const int lag0 = isctx ? (lt - 256) * 64 : lt * 64; const int c0 = ct * 64;
        const int prow = isctx ? 16384 + lag0 : lag0;
#pragma unroll
        for (int i = tid; i < 4096; i += NT) { const int r = i >> 6, u = i & 63; hd[r * 65 + u] = HDN[(size_t)(prow + r) * 64 + u]; wf[i] = w3[(size_t)r * 1024 + c0 + u]; wb[i] = w3[(size_t)r * 1024 + 512 + c0 + u]; }
        __syncthreads();
        { const int r = lane & 15, q = lane >> 4; const LAS float* bsrc = (wave < 4 ? wf : wb) + 16 * (wave & 3) + r;
          f32x4 acc[4];
#pragma unroll
          for (int mt = 0; mt < 4; ++mt) acc[mt] = (f32x4){0.f, 0.f, 0.f, 0.f};
#pragma unroll 4
          for (int kk = 0; kk < 16; ++kk) { const float bv = bsrc[(4 * kk + q) * 64];
#pragma unroll
              for (int mt = 0; mt < 4; ++mt) acc[mt] = __builtin_amdgcn_mfma_f32_16x16x4f32(hd[(16 * mt + r) * 65 + 4 * kk + q], bv, acc[mt], 0, 0, 0); }
#pragma unroll
          for (int mt = 0; mt < 4; ++mt)
#pragma unroll
              for (int e = 0; e < 4; ++e) ot[(16 * wave + r) * 65 + 16 * mt + 4 * q + e] = acc[mt][e]; }
        __syncthreads();
        float af[8], ab[8];
#pragma unroll
        for (int j = 0; j < 8; ++j) { af[j] = ot[(wave * 8 + j) * 65 + lane]; ab[j] = ot[(64 + wave * 8 + j) * 65 + lane]; }
        const int lag = lag0 + lane;
#pragma unroll
        for (int j = 0; j < 8; ++j) { const int c = c0 + wave * 8 + j;
            if (!isctx) { const float wn = hy_window(lag, 16384, c); float* slot = KT + (size_t)c * 32768;
                slot[lag] = af[j] * wn + (lag == 0 ? hb[c] : 0.f);
                if (lag == 0) slot[16384] = 0.f; else slot[32768 - lag] = ab[j] * wn;
            } else { const float wn = hy_window(lag, 256, c);
                HFC[(size_t)lag * 512 + c] = af[j] * wn + (lag == 0 ? hb[c] : 0.f); HFC[(size_t)(256 + lag) * 512 + c] = ab[j] * wn; } }
        __syncthreads();
    }
}
DI void fft_fwd_all(LAS cf* x) { const int tid = otid(); fft_fwd_pair(x, 0, tid, NT); __syncthreads(); fft_fwd_pair(x, 2, tid, NT); __syncthreads(); fft_fwd_stage(x, 4, tid, NT); __syncthreads(); fft16_fwd(x, tid, NT); __syncthreads(); }
DI void fft_inv_all(LAS cf* x) { const int tid = otid(); fft16_inv(x, tid, NT); __syncthreads(); fft_inv_stage(x, 4, tid, NT); __syncthreads(); fft_inv_pair(x, 2, tid, NT); __syncthreads(); fft_inv_pair(x, 0, tid, NT); __syncthreads(); }
DI void phase_filt3(PP4 P, LAS unsigned char* lds) {
    LAS cf* x = (LAS cf*)lds; const int tid = otid();
    for (int c = obid(); c < 512; c += ogrid()) {
        cf* slot = (cf*)(P->ws + O_K) + (size_t)c * FM;
#pragma unroll
        for (int hb = 0; hb < 2; ++hb) { cf tv[16];
#pragma unroll
            for (int i = 0; i < 16; ++i) tv[i] = slot[tid + NT * (16 * hb + i)];
#pragma unroll
            for (int i = 0; i < 16; ++i) x[PX(tid + NT * (16 * hb + i))] = tv[i]; }
        __syncthreads();
        fft_fwd_all(x);
        filt_unpack(x, slot, tid, NT);
        __syncthreads();
    }
}

DI const float* mod_rowptr(PP4 P, int R, bool from_input) {
    const int b = R / RB, rr = R - b * RB;
    return rr < CTX ? (from_input ? P->in[I_CTX] : (const float*)(P->ws + O_XCTX)) + ((size_t)b * CTX + rr) * D : (from_input ? P->in[I_X] : P->out) + ((size_t)b * SEQ + rr - CTX) * D;
}
DI void phase_modulate(PP4 P, int l, int which, int r_lo, int r_hi, bf16_t* hout  , bool from_input) {
    const int tid = otid(), wave = tid >> 6, lane = tid & 63;
    const float* gam = (which == 0 ? P->in[I_N1G] : P->in[I_N2G]) + l * 1024;
    const float* MOD = (const float*)(P->ws + O_MOD) + (size_t)l * 3 * 6144;
    const int stride = ogrid() * 8;
    int R = r_lo + obid() * 8 + wave;
    f32x4 v[4], vn[4];
    if (R < r_hi) { const float* xr = mod_rowptr(P, R, from_input);
#pragma unroll
        for (int j = 0; j < 4; ++j) v[j] = *(const f32x4*)(xr + 256 * j + 4 * lane); }
    for (; R < r_hi; R += stride) {
        if (R + stride < r_hi) { const float* xn = mod_rowptr(P, R + stride, from_input);
#pragma unroll
            for (int j = 0; j < 4; ++j) vn[j] = *(const f32x4*)(xn + 256 * j + 4 * lane); }
        const int b = R / RB, rr = R - b * RB; const bool isctx = rr < CTX;
        const float* mv = MOD + (isctx ? 2 : b) * 6144 + which * 3072;
        float s = 0.f;
#pragma unroll
        for (int j = 0; j < 4; ++j) s += v[j][0] * v[j][0] + v[j][1] * v[j][1] + v[j][2] * v[j][2] + v[j][3] * v[j][3];
        const float rs = rsqrtf(wave_sum(s) * (1.0f / 1024.0f) + 1e-6f);
        bf16_t* orow = hout + (size_t)(R - r_lo) * D;
#pragma unroll
        for (int j = 0; j < 4; ++j) { const int c = 256 * j + 4 * lane; const f32x4 g = *(const f32x4*)(gam + c), sh = *(const f32x4*)(mv + c), sc = *(const f32x4*)(mv + 1024 + c);
            const f32x4 y = v[j] * rs * g * (1.0f + sc) + sh;
            u32x2 w; w.x = pk2(y[0], y[1]); w.y = pk2(y[2], y[3]); *(u32x2*)(orow + c) = w; }
#pragma unroll
        for (int j = 0; j < 4; ++j) v[j] = vn[j];
    }
}

constexpr int S_CUM = 0, S_QIN = 40960, S_KK = 59392, S_SB = 77824, S_VT = 96256, S_HT = 114688;
constexpr int TS = 72;
constexpr int CS = 65;
DI int chain_pos(int d, int Bk) { return d == 0 ? Bk : (Bk < 4 ? 3 - Bk : 263 - Bk); }
template <int PH>
DI void scan_item(PP4 P, LAS unsigned char* lds, int l, int item) {
    const int tid = otid(), wave = __builtin_amdgcn_readfirstlane(tid >> 6), lane = tid & 63;
    const int mx = item / (NBLK * 4), rem = item % (NBLK * 4), Bk = rem >> 2, h = rem & 3;
    const int row0 = Bk * 64;
    const bf16_t* PP = (const bf16_t*)(P->ws + (mx == 0 ? O_PRET : O_PGLA));
    bf16_t* U = (bf16_t*)(P->ws + O_U); float* AB = (float*)(P->ws + O_ABUF);
    LAS float* cum = (LAS float*)(lds + S_CUM);
    float* CUMG = (float*)(P->ws + O_H);
    const float qs = mx == 0 ? 1.0f : 0.125f, ks = mx == 0 ? 0.125f : 1.0f;
    const int tok = tid >> 3, c8 = (tid & 7) * 8, c16 = (tid & 7) * 16; const bf16_t* prow = PP + (size_t)(row0 + tok) * 1536;
    const u32x4 kv = *(const u32x4*)(prow + 256 + 64 * h + c8);
    u32x4 qv = (u32x4){0u, 0u, 0u, 0u}; if (PH == 3) qv = *(const u32x4*)(prow + 64 * h + c8);
    const u32x4 v0 = *(const u32x4*)(prow + 512 + 128 * h + c16), v1 = *(const u32x4*)(prow + 512 + 128 * h + c16 + 8);
    u32x4 g0 = (u32x4){0u, 0u, 0u, 0u}, g1 = g0, hreg[4];
    if (PH == 3) { g0 = *(const u32x4*)(prow + 1024 + 128 * h + c16); g1 = *(const u32x4*)(prow + 1024 + 128 * h + c16 + 8);
#pragma unroll
        for (int i = 0; i < 4; ++i) { const int idx = tid + NT * i, d = idx >> 10, r2 = idx & 1023, dv = r2 >> 3, cc = (r2 & 7) * 8;
            const size_t ch = (size_t)((mx * 4 + h) * 2 + d) * NBLK + chain_pos(d, Bk);
            hreg[i] = *(const u32x4*)(U + ch * 8192 + dv * 64 + cc); } }
    if (PH == 3) {
    } else if (mx == 0) {
#pragma unroll
        for (int d = 0; d < 2; ++d) { const float la = log1pf(-exp2f(-(d == 0 ? 5.0f : 5.5f) - (float)h)); const float cv = d == 0 ? (float)(lane + 1) * la : (float)(64 - lane) * la;
#pragma unroll
            for (int j = 0; j < 8; ++j) cum[(d * 64 + lane) * CS + 8 * wave + j] = cv; }
    } else {
        LAS float* lrs = (LAS float*)(lds + S_SB);
        LAS float* wl = lrs + 64 * 36;
        { const f32x4 lt = *(const f32x4*)((const float*)(P->ws + O_LR) + (size_t)row0 * 32 + tid * 4); *(LAS f32x4*)(lrs + (tid >> 3) * 36 + (tid & 7) * 4) = lt;
          const int i4 = tid * 4, dd = i4 >> 10, rr = (i4 >> 6) & 15, cc = i4 & 63;
          *(LAS f32x4*)(wl + i4) = *(const f32x4*)(P->in[I_WA2] + ((size_t)(l * 2 + dd) * 16 + rr) * 256 + 64 * h + cc); }
        __syncthreads();
        { const int d = wave >> 2, ct = wave & 3, r = lane & 15, q = lane >> 4;
          const float bias = P->in[I_BA][(l * 2 + d) * 256 + 64 * h + 16 * ct + r];
          f32x4 acc[4];
#pragma unroll
          for (int mt = 0; mt < 4; ++mt) acc[mt] = (f32x4){bias, bias, bias, bias};
#pragma unroll
          for (int k4 = 0; k4 < 4; ++k4) { const float bv = wl[(d * 16 + 4 * k4 + q) * 64 + 16 * ct + r];
#pragma unroll
              for (int mt = 0; mt < 4; ++mt) acc[mt] = __builtin_amdgcn_mfma_f32_16x16x4f32(lrs[(16 * mt + r) * 36 + 16 * d + 4 * k4 + q], bv, acc[mt], 0, 0, 0); }
          float la[4][4], inc[4][4], pq[4], tm[4];
#pragma unroll
          for (int mt = 0; mt < 4; ++mt) { float run = 0.f;
#pragma unroll
              for (int e = 0; e < 4; ++e) { const float x = acc[mt][e]; la[mt][e] = (fminf(x, 0.f) - __logf(1.0f + __expf(-fabsf(x)))) * (1.0f / 16.0f); run += la[mt][e]; inc[mt][e] = run; }
              float t = run;
              { const float u1 = __shfl_up(t, 16); if (q >= 1) t += u1; const float u2 = __shfl_up(t, 32); if (q >= 2) t += u2; }
              pq[mt] = t - run;
              tm[mt] = __shfl(t, 48 + r); }
          float off = 0.f; const float total = (tm[0] + tm[1]) + (tm[2] + tm[3]);
#pragma unroll
          for (int mt = 0; mt < 4; ++mt) {
#pragma unroll
              for (int e = 0; e < 4; ++e) { const float pf = off + pq[mt] + inc[mt][e];
                  cum[(d * 64 + 16 * mt + 4 * q + e) * CS + 16 * ct + r] = d == 0 ? pf : total - pf + la[mt][e]; }
              off += tm[mt]; } }
    }
    if (PH == 1) __syncthreads();
    LAS bf16_t* qin = (LAS bf16_t*)(lds + S_QIN); LAS bf16_t* kk = (LAS bf16_t*)(lds + S_KK); LAS bf16_t* sb = (LAS bf16_t*)(lds + S_SB);
    LAS bf16_t* vT = (LAS bf16_t*)(lds + S_VT); LAS bf16_t* hT = (LAS bf16_t*)(lds + S_HT);
    { float kf[8], qf[8];
#pragma unroll
      for (int j = 0; j < 4; ++j) { kf[2 * j] = __uint_as_float(kv[j] << 16) * ks; kf[2 * j + 1] = __uint_as_float(kv[j] & 0xffff0000u) * ks; qf[2 * j] = __uint_as_float(qv[j] << 16) * qs; qf[2 * j + 1] = __uint_as_float(qv[j] & 0xffff0000u) * qs; }
#pragma unroll
      for (int d = 0; d < 2; ++d) {
          if (PH == 3) { float qo[8], ko[8];
              float cu8[8];
              if (mx == 0) { const float la = log1pf(-exp2f(-(d == 0 ? 5.0f : 5.5f) - (float)h)); const float cv = d == 0 ? (float)(tok + 1) * la : (float)(64 - tok) * la;
#pragma unroll
                  for (int j = 0; j < 8; ++j) cu8[j] = cv;
              } else { const float* cg = CUMG + ((size_t)d * RB + row0 + tok) * 256 + 64 * h + c8; const f32x4 ca = *(const f32x4*)cg, cb2 = *(const f32x4*)(cg + 4);
#pragma unroll
                  for (int j = 0; j < 4; ++j) { cu8[j] = ca[j]; cu8[4 + j] = cb2[j]; } }
#pragma unroll
              for (int j = 0; j < 8; ++j) { const float cu = cu8[j]; qo[j] = qf[j] * __expf(cu); ko[j] = kf[j] * __expf(-cu); }
              u32x4 w; w.x = pk2(qo[0], qo[1]); w.y = pk2(qo[2], qo[3]); w.z = pk2(qo[4], qo[5]); w.w = pk2(qo[6], qo[7]); *(LAS u32x4*)(qin + (d * 64 + tok) * TS + c8) = w;
              w.x = pk2(ko[0], ko[1]); w.y = pk2(ko[2], ko[3]); w.z = pk2(ko[4], ko[5]); w.w = pk2(ko[6], ko[7]); *(LAS u32x4*)(kk + (d * 64 + tok) * TS + c8) = w;
          } else {
              float cu8[8];
#pragma unroll
              for (int j = 0; j < 8; ++j) { const int ch = c8 + j; const float tot = d == 0 ? cum[63 * CS + ch] : cum[64 * CS + ch]; const float cu = cum[(d * 64 + tok) * CS + ch]; cu8[j] = cu;
                  qin[(d * 64 + ch) * TS + (tok ^ (((ch >> 3) & 7) << 3))] = f2bf(kf[j] * __expf(tot - cu)); }
              if (mx == 1) { float* cg = CUMG + ((size_t)d * RB + row0 + tok) * 256 + 64 * h + c8;
                  *(f32x4*)cg = (f32x4){cu8[0], cu8[1], cu8[2], cu8[3]}; *(f32x4*)(cg + 4) = (f32x4){cu8[4], cu8[5], cu8[6], cu8[7]}; }
          } }
#pragma unroll
      for (int j = 0; j < 4; ++j) { const int tsw = tok ^ ((tid & 7) << 3);
          vT[(c16 + 2 * j) * TS + tsw] = (bf16_t)(v0[j] & 0xffffu); vT[(c16 + 2 * j + 1) * TS + tsw] = (bf16_t)(v0[j] >> 16);
          vT[(c16 + 8 + 2 * j) * TS + tsw] = (bf16_t)(v1[j] & 0xffffu); vT[(c16 + 8 + 2 * j + 1) * TS + tsw] = (bf16_t)(v1[j] >> 16); }
      if (PH == 3) {
#pragma unroll
          for (int i = 0; i < 4; ++i) { const int idx = tid + NT * i, d = idx >> 10, r2 = idx & 1023, dv = r2 >> 3, cc = (r2 & 7) * 8; *(LAS u32x4*)(hT + (d * 128 + dv) * TS + cc) = hreg[i]; } }
    }
    __syncthreads();
    const int d = wave >> 2, s = wave & 3, fr = lane & 15, fq = lane >> 4;
    if (PH == 1) {
        f32x4 u[4][2];
#pragma unroll
        for (int mi = 0; mi < 4; ++mi)
#pragma unroll
            for (int ni = 0; ni < 2; ++ni) u[mi][ni] = (f32x4){0.f, 0.f, 0.f, 0.f};
#pragma unroll
        for (int kst = 0; kst < 2; ++kst) { bf16x8 bv[2];
#pragma unroll
            for (int ni = 0; ni < 2; ++ni) bv[ni] = *(const LAS bf16x8*)(vT + (16 * (2 * s + ni) + fr) * TS + ((kst * 32 + fq * 8) ^ (((2 * s + ni) & 7) << 3)));
#pragma unroll
            for (int mi = 0; mi < 4; ++mi) { const bf16x8 a = *(const LAS bf16x8*)(qin + (d * 64 + 16 * mi + fr) * TS + ((kst * 32 + fq * 8) ^ (((2 * mi + (fr >> 3)) & 7) << 3)));
#pragma unroll
                for (int ni = 0; ni < 2; ++ni) u[mi][ni] = __builtin_amdgcn_mfma_f32_16x16x32_bf16(a, bv[ni], u[mi][ni], 0, 0, 0); } }
        const size_t chn = (size_t)((mx * 4 + h) * 2 + d) * NBLK + chain_pos(d, Bk);
        if (s == 0) AB[chn * 64 + lane] = __expf(d == 0 ? cum[63 * CS + lane] : cum[64 * CS + lane]);
#pragma unroll
        for (int mi = 0; mi < 4; ++mi)
#pragma unroll
            for (int ni = 0; ni < 2; ++ni) { u32x2 w; w.x = pk2(u[mi][ni][0], u[mi][ni][1]); w.y = pk2(u[mi][ni][2], u[mi][ni][3]);
                *(LAS u32x2*)(hT + (d * 128 + 16 * (2 * s + ni) + fr) * TS + 16 * mi + 4 * fq) = w; }
        __syncthreads();
#pragma unroll
        for (int i = 0; i < 4; ++i) { const int idx = tid + NT * i, dd = idx >> 10, r2 = idx & 1023, dv = r2 >> 3, cc = (r2 & 7) * 8;
            const size_t ch2 = (size_t)((mx * 4 + h) * 2 + dd) * NBLK + chain_pos(dd, Bk);
            *(u32x4*)(U + ch2 * 8192 + dv * 64 + cc) = *(const LAS u32x4*)(hT + (dd * 128 + dv) * TS + cc); }
        __syncthreads();
    } else {
        f32x4 sc[4];
#pragma unroll
        for (int nt = 0; nt < 4; ++nt) sc[nt] = (f32x4){0.f, 0.f, 0.f, 0.f};
#pragma unroll
        for (int kst = 0; kst < 2; ++kst) { const bf16x8 a = *(const LAS bf16x8*)(qin + (d * 64 + 16 * s + fr) * TS + kst * 32 + fq * 8);
#pragma unroll
            for (int nt = 0; nt < 4; ++nt) { const bf16x8 b = *(const LAS bf16x8*)(kk + (d * 64 + 16 * nt + fr) * TS + kst * 32 + fq * 8);
                sc[nt] = __builtin_amdgcn_mfma_f32_16x16x32_bf16(a, b, sc[nt], 0, 0, 0); } }
#pragma unroll
        for (int nt = 0; nt < 4; ++nt)
#pragma unroll
            for (int r = 0; r < 4; ++r) { const int i = 16 * s + fq * 4 + r, j = 16 * nt + fr; const bool keep = d == 0 ? (j <= i) : (j > i);
                sb[(d * 64 + i) * TS + j] = f2bf(keep ? sc[nt][r] : 0.f); }
        __syncthreads();
        f32x4 o[8];
#pragma unroll
        for (int nt = 0; nt < 8; ++nt) o[nt] = (f32x4){0.f, 0.f, 0.f, 0.f};
#pragma unroll
        for (int kst = 0; kst < 2; ++kst) { const bf16x8 a = *(const LAS bf16x8*)(sb + (d * 64 + 16 * s + fr) * TS + kst * 32 + fq * 8);
            const bf16x8 a2 = *(const LAS bf16x8*)(qin + (d * 64 + 16 * s + fr) * TS + kst * 32 + fq * 8);
#pragma unroll
            for (int nt = 0; nt < 8; ++nt) { const bf16x8 b = *(const LAS bf16x8*)(vT + (16 * nt + fr) * TS + ((kst * 32 + fq * 8) ^ ((nt & 7) << 3)));
                o[nt] = __builtin_amdgcn_mfma_f32_16x16x32_bf16(a, b, o[nt], 0, 0, 0);
                const bf16x8 b2 = *(const LAS bf16x8*)(hT + (d * 128 + 16 * nt + fr) * TS + kst * 32 + fq * 8);
                o[nt] = __builtin_amdgcn_mfma_f32_16x16x32_bf16(a2, b2, o[nt], 0, 0, 0); } }
        __syncthreads();
        LAS float* ob = (LAS float*)(lds + (d == 0 ? S_CUM : S_QIN));
#pragma unroll
        for (int nt = 0; nt < 8; ++nt)
#pragma unroll
            for (int r = 0; r < 4; ++r) ob[(16 * s + fq * 4 + r) * 132 + 16 * nt + fr] = o[nt][r];
        __syncthreads();
        { const LAS float* p0 = (const LAS float*)(lds + S_CUM) + tok * 132 + c16; const LAS float* p1 = (const LAS float*)(lds + S_QIN) + tok * 132 + c16;
          float v[16]; float sm = 0.f;
#pragma unroll
          for (int j = 0; j < 4; ++j) { const f32x4 a4 = *(const LAS f32x4*)(p0 + 4 * j), b4 = *(const LAS f32x4*)(p1 + 4 * j);
#pragma unroll
              for (int e = 0; e < 4; ++e) { v[4 * j + e] = a4[e] + b4[e]; sm += v[4 * j + e]; } }
          sm += __shfl_xor(sm, 1); sm += __shfl_xor(sm, 2); sm += __shfl_xor(sm, 4);
          const float mu = sm * (1.0f / 128.0f); float vs = 0.f;
#pragma unroll
          for (int j = 0; j < 16; ++j) { const float dd = v[j] - mu; vs += dd * dd; }
          vs += __shfl_xor(vs, 1); vs += __shfl_xor(vs, 2); vs += __shfl_xor(vs, 4);
          const float rstd = rsqrtf(vs * (1.0f / 128.0f) + 1e-5f);
          bf16_t* BR = (bf16_t*)(P->ws + O_PHY); bf16_t* orow = BR + (size_t)(row0 + tok) * 1536 + mx * 512 + 128 * h + c16;
          u32x4 w0, w1;
#pragma unroll
          for (int j = 0; j < 4; ++j) {
              w0[j] = pk2((v[2 * j] - mu) * rstd * silu_f(__uint_as_float(g0[j] << 16)), (v[2 * j + 1] - mu) * rstd * silu_f(__uint_as_float(g0[j] & 0xffff0000u)));
              w1[j] = pk2((v[8 + 2 * j] - mu) * rstd * silu_f(__uint_as_float(g1[j] << 16)), (v[8 + 2 * j + 1] - mu) * rstd * silu_f(__uint_as_float(g1[j] & 0xffff0000u))); }
          *(u32x4*)orow = w0; *(u32x4*)(orow + 8) = w1; }
        __syncthreads();
    }
}
DI void phase_scan2(PP4 P) {
    const int tid = otid(), bidx = obid(), G = ogrid();
    if (tid < 128) {
        for (int g = bidx * 128 + tid; g < 32768; g += G * 128) {
            const int chain = g >> 11, e4 = g & 2047, dk = (4 * e4) & 63;
            u32x2* up = (u32x2*)((bf16_t*)(P->ws + O_U) + (size_t)chain * NBLK * 8192 + 4 * e4); const float* ap = (const float*)(P->ws + O_ABUF) + (size_t)chain * NBLK * 64 + dk;
            f32x4 h = (f32x4){0.f, 0.f, 0.f, 0.f};
            for (int j0 = 0; j0 < NBLK; j0 += 20) {
                u32x2 u[20]; f32x4 a[20];
#pragma unroll
                for (int i = 0; i < 20; ++i) { u[i] = up[(size_t)(j0 + i) * 2048]; a[i] = *(const f32x4*)(ap + (j0 + i) * 64); }
#pragma unroll
                for (int i = 0; i < 20; ++i) { u32x2 w; w.x = pk2(h[0], h[1]); w.y = pk2(h[2], h[3]); up[(size_t)(j0 + i) * 2048] = w;
                    h[0] = a[i][0] * h[0] + __uint_as_float(u[i].x << 16); h[1] = a[i][1] * h[1] + __uint_as_float(u[i].x & 0xffff0000u);
                    h[2] = a[i][2] * h[2] + __uint_as_float(u[i].y << 16); h[3] = a[i][3] * h[3] + __uint_as_float(u[i].y & 0xffff0000u); }
            }
        }
    }
}

struct Hy1Regs { u32x4 p[3][3]; };
DI void hy1_load(PP4 P, int item, int tid, Hy1Regs& R) {
    const int tb = item >> 3, ct = item & 7, t0 = tb * 64, c0 = ct * 64;
    const bf16_t* PH_ = (const bf16_t*)(P->ws + O_PHY);
    const int tok = tid >> 3, c8 = (tid & 7) * 8, r = t0 + tok, c = c0 + c8;
    const bool hp = (r != 0) && (r != CTX), hn = (r != CTX - 1) && (r != RB - 1);
    const u32x4 z4 = (u32x4){0u, 0u, 0u, 0u};
#pragma unroll
    for (int gsel = 0; gsel < 3; ++gsel) { const int col = gsel * 512 + c;
        R.p[gsel][0] = hp ? *(const u32x4*)(PH_ + (size_t)(r - 1) * 1536 + col) : z4; R.p[gsel][1] = *(const u32x4*)(PH_ + (size_t)r * 1536 + col); R.p[gsel][2] = hn ? *(const u32x4*)(PH_ + (size_t)(r + 1) * 1536 + col) : z4; }
}
DI void hy1_weights(PP4 P, LAS unsigned char* lds, int l, int ct, int tid) {
    LAS float* wl = (LAS float*)(lds + 16384);
    const float* sw = P->in[I_SHW] + (size_t)l * 3 * 1536; const float* sbv = P->in[I_SHB] + l * 1536;
    __syncthreads();
    for (int idx = tid; idx < 768; idx += NT) { const int k = idx / 192, rem = idx - k * 192, gsel = rem >> 6, ch = rem & 63; const int col = gsel * 512 + ct * 64 + ch;
        wl[idx] = k == 0 ? sbv[col] : sw[(k - 1) * 1536 + col]; }
    __syncthreads();
}
DI void hy1_item(PP4 P, LAS unsigned char* lds, int l, int item, int tid, const Hy1Regs& R) {
    const int tb = item >> 3, ct = item & 7, t0 = tb * 64, c0 = ct * 64;
    bf16_t* X0 = (bf16_t*)(P->ws + O_X0C); bf16_t* ZT = (bf16_t*)(P->ws + O_ZT); float* ZC = (float*)(P->ws + O_ZCTX);
    LAS bf16_t* zt = (LAS bf16_t*)lds;
    const int tok = tid >> 3, c8 = (tid & 7) * 8, r = t0 + tok, c = c0 + c8;
    const LAS float* wl = (const LAS float*)(lds + 16384);
    float uo[3][8];
#pragma unroll
    for (int gsel = 0; gsel < 3; ++gsel) {
        const u32x4 pm = R.p[gsel][0], pc = R.p[gsel][1], pn = R.p[gsel][2];
        f32x4 wv[4][2];
#pragma unroll
        for (int k = 0; k < 2; ++k) { wv[0][k] = *(const LAS f32x4*)(wl + (0 * 3 + gsel) * 64 + c8 + 4 * k); wv[1][k] = *(const LAS f32x4*)(wl + (1 * 3 + gsel) * 64 + c8 + 4 * k); wv[2][k] = *(const LAS f32x4*)(wl + (2 * 3 + gsel) * 64 + c8 + 4 * k); wv[3][k] = *(const LAS f32x4*)(wl + (3 * 3 + gsel) * 64 + c8 + 4 * k); }
#pragma unroll
        for (int j = 0; j < 8; ++j) { const unsigned a = pm[j >> 1], b = pc[j >> 1], cw = pn[j >> 1];
            const float fa = (j & 1) ? __uint_as_float(a & 0xffff0000u) : __uint_as_float(a << 16), fb = (j & 1) ? __uint_as_float(b & 0xffff0000u) : __uint_as_float(b << 16), fc = (j & 1) ? __uint_as_float(cw & 0xffff0000u) : __uint_as_float(cw << 16);
            uo[gsel][j] = wv[0][j >> 2][j & 3] + fa * wv[1][j >> 2][j & 3] + fb * wv[2][j >> 2][j & 3] + fc * wv[3][j >> 2][j & 3]; } }
    { u32x4 w; w.x = pk2(uo[0][0], uo[0][1]); w.y = pk2(uo[0][2], uo[0][3]); w.z = pk2(uo[0][4], uo[0][5]); w.w = pk2(uo[0][6], uo[0][7]); *(u32x4*)(X0 + (size_t)r * 512 + c) = w; }
    if (t0 < CTX) {
        float* zp = ZC + (size_t)r * 512 + c;
        *(f32x4*)zp = (f32x4){uo[1][0] * uo[2][0], uo[1][1] * uo[2][1], uo[1][2] * uo[2][2], uo[1][3] * uo[2][3]}; *(f32x4*)(zp + 4) = (f32x4){uo[1][4] * uo[2][4], uo[1][5] * uo[2][5], uo[1][6] * uo[2][6], uo[1][7] * uo[2][7]};
    } else {
#pragma unroll
        for (int j = 0; j < 8; ++j) zt[(c8 + j) * TS + (tok ^ ((tid & 7) << 3))] = f2bf(uo[1][j] * uo[2][j]);
        __syncthreads();
        const int ch = tid >> 3, p8 = (tid & 7) * 8;
        *(u32x4*)(ZT + (size_t)(c0 + ch) * SEQ + (t0 - CTX) + p8) = *(const LAS u32x4*)(zt + ch * TS + (p8 ^ (((ch >> 3) & 7) << 3)));
        __syncthreads();
    }
}
DI void hy2_item(PP4 P, LAS unsigned char* lds, int c) {
    LAS cf* x = (LAS cf*)lds; const int tid = otid();
    unsigned* zrow = (unsigned*)((bf16_t*)(P->ws + O_ZT) + (size_t)c * SEQ);
    const cf* K = (const cf*)(P->ws + O_K) + (size_t)c * FM;
    { unsigned wv[16];
#pragma unroll
      for (int i = 0; i < 16; ++i) wv[i] = zrow[tid + NT * i];
#pragma unroll
      for (int i = 0; i < 16; ++i) { cf v; v.x = __uint_as_float(wv[i] << 16); v.y = __uint_as_float(wv[i] & 0xffff0000u); x[PX(tid + NT * i)] = v; cf z; z.x = 0.f; z.y = 0.f; x[PX(8192 + tid + NT * i)] = z; } }
    __syncthreads();
    fft_fwd_all(x);
    conv_pointwise(x, K, tid, NT);
    __syncthreads();
    fft_inv_all(x);
    for (int m = tid; m < 8192; m += NT) { const cf v = x[PX(m)]; zrow[m] = pk2(v.x, v.y); }
    __syncthreads();
}
DI void hy3_item(PP4 P, LAS unsigned char* lds, int item, bool last) {
    const int tid = otid(); const int tb = item >> 3, ct = item & 7, t0 = tb * 64, c0 = ct * 64;
    if (t0 < CTX && last) return;
    const bf16_t* X0 = (const bf16_t*)(P->ws + O_X0C); const bf16_t* ZT = (const bf16_t*)(P->ws + O_ZT); bf16_t* BR = (bf16_t*)(P->ws + O_PHY);
    const int tok = tid >> 3, c8 = (tid & 7) * 8, r = t0 + tok, c = c0 + c8;
    float y[8];
    if (t0 < CTX) {
        const float* ZC = (const float*)(P->ws + O_ZCTX); const float* HFC = (const float*)(P->ws + O_HFC);
        LAS float* zs = (LAS float*)lds;
        LAS float* hf = zs + 256 * 64;
#pragma unroll 8
        for (int idx = tid; idx < 256 * 64; idx += NT) { const int sidx = idx >> 6, ch = idx & 63; zs[idx] = ZC[(size_t)sidx * 512 + c0 + ch]; }
#pragma unroll 8
        for (int idx = tid; idx < 319 * 64; idx += NT) { const int li = idx >> 6, ch = idx & 63, lag = li + t0 - 255;
            hf[li * 68 + ch] = lag >= 0 ? HFC[(size_t)lag * 512 + c0 + ch] : HFC[(size_t)(256 - lag) * 512 + c0 + ch]; }
        __syncthreads();
#pragma unroll
        for (int j = 0; j < 8; ++j) y[j] = 0.f;
#pragma unroll 4
        for (int sidx = 0; sidx < CTX; ++sidx) { const int li = tok - sidx + 255;
            const f32x4 h0 = *(const LAS f32x4*)(hf + li * 68 + c8), h1 = *(const LAS f32x4*)(hf + li * 68 + c8 + 4), z0 = *(const LAS f32x4*)(zs + sidx * 64 + c8), z1 = *(const LAS f32x4*)(zs + sidx * 64 + c8 + 4);
#pragma unroll
            for (int j = 0; j < 4; ++j) { y[j] += h0[j] * z0[j]; y[4 + j] += h1[j] * z1[j]; } }
    } else {
        LAS bf16_t* yt = (LAS bf16_t*)lds;
        const int ch = tid >> 3, p8 = (tid & 7) * 8;
        *(LAS u32x4*)(yt + ch * TS + (p8 ^ (((ch >> 3) & 7) << 3))) = *(const u32x4*)(ZT + (size_t)(c0 + ch) * SEQ + (t0 - CTX) + p8);
        __syncthreads();
#pragma unroll
        for (int j = 0; j < 8; ++j) y[j] = bf2f(yt[(c8 + j) * TS + (tok ^ ((tid & 7) << 3))]);
    }
    const u32x4 xv = *(const u32x4*)(X0 + (size_t)r * 512 + c);
    float o[8];
#pragma unroll
    for (int j = 0; j < 4; ++j) { o[2 * j] = __uint_as_float(xv[j] << 16) * y[2 * j]; o[2 * j + 1] = __uint_as_float(xv[j] & 0xffff0000u) * y[2 * j + 1]; }
    u32x4 w; w.x = pk2(o[0], o[1]); w.y = pk2(o[2], o[3]); w.z = pk2(o[4], o[5]); w.w = pk2(o[6], o[7]);
    *(u32x4*)(BR + (size_t)r * 1536 + 1024 + c) = w;
    __syncthreads();
}

DI f32x2 gelu_pk(f32x2 v) {
    const f32x2 av = __builtin_elementwise_abs(v), dd = av * 0.2316418882f + 1.0f;
    f32x2 t; t.x = __builtin_amdgcn_rcpf(dd.x); t.y = __builtin_amdgcn_rcpf(dd.y);
    f32x2 q = t * 0.5307027145f + (-0.7265760135f); q = q * t + 0.7107068705f; q = q * t + (-0.142248368f); q = q * t + 0.127414796f; q = q * t;
    const f32x2 sx = (v * v) * (-0.72134752044f);
    f32x2 e; e.x = __builtin_amdgcn_exp2f(sx.x); e.y = __builtin_amdgcn_exp2f(sx.y);
    const f32x2 m = v * (q * e), r = v - m;
    f32x2 o; o.x = v.x < 0.f ? m.x : r.x; o.y = v.y < 0.f ? m.y : r.y; return o;
}
DI void cg_unpack(const u32x4 av, f32x2 (&o)[4]) {
#pragma unroll
    for (int j = 0; j < 4; ++j) { o[j].x = __uint_as_float(av[j] << 16); o[j].y = __uint_as_float(av[j] & 0xffff0000u); }
}
DI void cg_finish(const f32x2 (&acc)[4], const u32x4 vv, bf16_t* vp) {
    u32x4 w;
#pragma unroll
    for (int j = 0; j < 4; ++j) { const f32x2 gl = gelu_pk(acc[j]); w[j] = pg8::cvt_pk_bf16(gl.x * __uint_as_float(vv[j] << 16), gl.y * __uint_as_float(vv[j] & 0xffff0000u)); }
    *(u32x4*)vp = w;
}
DI void phase_convglu(PP4 P, int l) {
    const bf16_t* A = (const bf16_t*)(P->ws + O_A); bf16_t* V = (bf16_t*)(P->ws + O_V);
    const float* cw = P->in[I_FCW] + (size_t)l * 9 * DFF; const float* cb = P->in[I_FCB] + (size_t)l * DFF;
    const int gtid = obid() * NT + otid(), gstride = ogrid() * NT;
    const u32x4 z4 = (u32x4){0u, 0u, 0u, 0u};
    for (int g = gtid; g < 2 * 16 * 64 * 352; g += gstride) {
        const int ck = g % 352, r1 = g / 352, gw = r1 & 63, r2 = r1 >> 6, seg = r2 & 15, b = r2 >> 4; const int c = ck * 8;
        const size_t base = (size_t)b * RB + CTX; const bool hl = gw > 0, hr = gw < 63;
        const int gr0 = seg * 16;
        f32x2 w[9][4];
#pragma unroll
        for (int k = 0; k < 9; ++k) { const f32x4 w0 = *(const f32x4*)(cw + (size_t)k * DFF + c), w1 = *(const f32x4*)(cw + (size_t)k * DFF + c + 4);
            w[k][0] = (f32x2){w0[0], w0[1]}; w[k][1] = (f32x2){w0[2], w0[3]}; w[k][2] = (f32x2){w1[0], w1[1]}; w[k][3] = (f32x2){w1[2], w1[3]}; }
        const f32x4 b0 = *(const f32x4*)(cb + c), b1 = *(const f32x4*)(cb + c + 4);
        f32x2 wA[3][4], wB[3][4], wC[3][4];
        { const int gra = gr0 - 1; const bool ok = gra >= 0; const bf16_t* rp = A + (base + (size_t)gra * 64 + gw) * DFF + c;
          cg_unpack((ok && hl) ? *(const u32x4*)(rp - DFF) : z4, wA[0]); cg_unpack(ok ? *(const u32x4*)rp : z4, wA[1]); cg_unpack((ok && hr) ? *(const u32x4*)(rp + DFF) : z4, wA[2]);
          const bf16_t* rq = A + (base + (size_t)gr0 * 64 + gw) * DFF + c;
          cg_unpack(hl ? *(const u32x4*)(rq - DFF) : z4, wB[0]); cg_unpack(*(const u32x4*)rq, wB[1]); cg_unpack(hr ? *(const u32x4*)(rq + DFF) : z4, wB[2]); }
        u32x4 nx[3], vn;
        { const bf16_t* rp = A + (base + (size_t)(gr0 + 1) * 64 + gw) * DFF + c;
          nx[0] = hl ? *(const u32x4*)(rp - DFF) : z4; nx[1] = *(const u32x4*)rp; nx[2] = hr ? *(const u32x4*)(rp + DFF) : z4;
          vn = *(const u32x4*)(V + (base + (size_t)gr0 * 64 + gw) * DFF + c); }
#define CG_STEP(T, M, B, RR) do { const int rr_ = (RR); const int gr = gr0 + rr_; \
            cg_unpack(nx[0], B[0]); cg_unpack(nx[1], B[1]); cg_unpack(nx[2], B[2]); \
            const u32x4 vc = vn; \
            if (rr_ < 15) { const bool ok = gr + 2 < 256; const bf16_t* rp = A + (base + (size_t)(gr + 2) * 64 + gw) * DFF + c; \
                nx[0] = (ok && hl) ? *(const u32x4*)(rp - DFF) : z4; nx[1] = ok ? *(const u32x4*)rp : z4; nx[2] = (ok && hr) ? *(const u32x4*)(rp + DFF) : z4; \
                vn = *(const u32x4*)(V + (base + (size_t)(gr + 1) * 64 + gw) * DFF + c); } \
            f32x2 acc[4] = {(f32x2){b0[0], b0[1]}, (f32x2){b0[2], b0[3]}, (f32x2){b1[0], b1[1]}, (f32x2){b1[2], b1[3]}}; \
            _Pragma("unroll") for (int j = 0; j < 3; ++j) _Pragma("unroll") for (int k = 0; k < 4; ++k) { acc[k] += T[j][k] * w[j][k]; acc[k] += M[j][k] * w[3 + j][k]; acc[k] += B[j][k] * w[6 + j][k]; } \
            cg_finish(acc, vc, V + (base + (size_t)gr * 64 + gw) * DFF + c); } while (0)
        for (int r3 = 0; r3 < 15; r3 += 3) { CG_STEP(wA, wB, wC, r3); CG_STEP(wB, wC, wA, r3 + 1); CG_STEP(wC, wA, wB, r3 + 2); }
        CG_STEP(wA, wB, wC, 15);
#undef CG_STEP
    }
    for (int g = gtid; g < 2 * 256 * 352; g += gstride) {
        const int ck = g % 352, r1 = g / 352, t = r1 & 255, b = r1 >> 8; const int c = ck * 8; const size_t row = (size_t)b * RB + t;
        const f32x4 b0 = *(const f32x4*)(cb + c), b1 = *(const f32x4*)(cb + c + 4);
        f32x2 acc[4] = {(f32x2){b0[0], b0[1]}, (f32x2){b0[2], b0[3]}, (f32x2){b1[0], b1[1]}, (f32x2){b1[2], b1[3]}};
#pragma unroll
        for (int j = 0; j < 3; ++j) { const int tt = t + j - 1; if (tt < 0 || tt > 255) continue;
            f32x2 av[4]; cg_unpack(*(const u32x4*)(A + ((size_t)b * RB + tt) * DFF + c), av);
            const f32x4 w0 = *(const f32x4*)(cw + (size_t)(3 + j) * DFF + c), w1 = *(const f32x4*)(cw + (size_t)(3 + j) * DFF + c + 4);
            acc[0] += av[0] * (f32x2){w0[0], w0[1]}; acc[1] += av[1] * (f32x2){w0[2], w0[3]}; acc[2] += av[2] * (f32x2){w1[0], w1[1]}; acc[3] += av[3] * (f32x2){w1[2], w1[3]}; }
        cg_finish(acc, *(const u32x4*)(V + row * DFF + c), V + row * DFF + c);
    }
}
DI void phase_final(PP4 P) {
    const int tid = otid(), wave = tid >> 6, lane = tid & 63; const float* gam = P->in[I_FING];
    const int stride = ogrid() * 8; int R = obid() * 8 + wave;
    f32x4 v[4], vn[4];
    if (R < NB * SEQ) {
#pragma unroll
        for (int j = 0; j < 4; ++j) v[j] = *(const f32x4*)(P->out + (size_t)R * D + 256 * j + 4 * lane); }
    for (; R < NB * SEQ; R += stride) {
        if (R + stride < NB * SEQ) {
#pragma unroll
            for (int j = 0; j < 4; ++j) vn[j] = *(const f32x4*)(P->out + (size_t)(R + stride) * D + 256 * j + 4 * lane); }
        float* xr = P->out + (size_t)R * D; float s = 0.f;
#pragma unroll
        for (int j = 0; j < 4; ++j) s += v[j][0] * v[j][0] + v[j][1] * v[j][1] + v[j][2] * v[j][2] + v[j][3] * v[j][3];
        const float rs = rsqrtf(wave_sum(s) * (1.0f / 1024.0f) + 1e-6f);
#pragma unroll
        for (int j = 0; j < 4; ++j) { const int c = 256 * j + 4 * lane; __builtin_nontemporal_store(v[j] * rs * *(const f32x4*)(gam + c), (f32x4*)(xr + c)); }
#pragma unroll
        for (int j = 0; j < 4; ++j) v[j] = vn[j];
    }
}

DI int hy_pick(int scheme, int G, int b, int k) {
    if (G != 256) { const int it = b + G * k; return it < 2080 ? it : -1; }
    if (scheme == 0) { if (b < 32) return k < 4 ? 4 * b + k : -1; const int it = 96 + b + 224 * k; return it < 2080 ? it : -1; }
    if (b < 32) return k < 4 ? 32 + 4 * b + k : -1;
    if (b < 64) return k == 0 ? b - 32 : -1;
    const int it = 96 + b + 192 * k; return it < 2080 ? it : -1;
}

__global__ void __launch_bounds__(NT, 2) fwd_megakernel(Params Pk) {
    extern __shared__ __attribute__((aligned(16))) unsigned char lds_raw[];
    LAS unsigned char* lds = (LAS unsigned char*)lds_raw;
    cg::grid_group grid = cg::this_grid();
    volatile LAS unsigned* bst = (volatile LAS unsigned*)(lds + LDS_BYTES - 16);
    if (threadIdx.x == 0) { bst[0] = 0u; bst[1] = 0u; }
    __syncthreads();
    const XcdBarrier xbar = xcd_barrier_post((unsigned*)(getP()->ws + O_BAR), bst);
#define GSYNC() do { xcd_barrier(xbar); if (PROBE == 1) xcd_barrier(xbar); } while (0)
    const int G = gridDim.x, bid = blockIdx.x;
#define P getP()
#define WT ((bf16_t*)(P->ws + O_WT))
    if (PON(0)) phase_adaln(P, lds);
#pragma unroll 1
    for (int l0 = 0; l0 < 2; ++l0) {
        int l = l0; asm volatile("" : "+s"(l));
        const bool first = l == 0, last = l == 1;
        if (l == 0 || G != 256) { RPT(5) if (PON(1)) phase_wconv(P, lds, l, 0, WT_T_DN, bid, G); } else phase_wconv(P, lds, l, WT_T_UP, WT_T_DN, bid, G);
        if (l == 0 || G != 256) { RPT(7) if (PON(2)) phase_filt1(P, lds, l, bid, G); }
        if (l == 0) grid.sync(); else if (G != 256) GSYNC();
        if (PON(3)) phase_filt2(P, lds, l);
        RPT(8) if (PON(5)) phase_modulate(P, l, 0, 0, RB, (bf16_t*)(P->ws + O_H), first);
        GSYNC();
#pragma unroll 1
        for (int b0 = 0; b0 < NB; ++b0) {
            int b = b0; asm volatile("" : "+s"(b));
            { pg8::Gemm g{(const bf16_t*)(P->ws + (b == 0 ? O_H : O_U)), WT + WT_IN, 1024, 1024, 1024, 0, 0}; pg8::Sched S; S.init(RB / 256, NIN / 256, G, bid, 0, 1);
              pg8::EpiWin E{(bf16_t*)(P->ws + O_PRET), (bf16_t*)(P->ws + O_PGLA), (bf16_t*)(P->ws + O_PHY), (bf16_t*)(P->ws + O_GATES), (float*)(P->ws + O_LR)};
              RPT(2) if (PON(6)) pg8::gemm_phase(lds, g, S, E); }
            if (b == 0 && PON(4)) phase_filt3(P, lds);
            GSYNC();
            { const int tidh = otid(); int wct = -1;
              for (int k = 0;; ++k) { const int it = hy_pick(0, G, bid, k); if (it < 0) break; Hy1Regs ha; hy1_load(P, it, tidh, ha); if ((it & 7) != wct) { wct = it & 7; hy1_weights(P, lds, l, wct, tidh); } hy1_item(P, lds, l, it, tidh, ha); }
              for (int rp_ = 0; rp_ < (PROBE == 14 ? 2 : 1); ++rp_) for (int it = bid; it < 2080; it += G) scan_item<1>(P, lds, l, it); }
            GSYNC();
            if (PON(9)) for (int c = bid; c < 512; c += G) hy2_item(P, lds, c);
            if (PON(10)) phase_scan2(P);
            GSYNC();
            if (PROBE == 3) { for (int it = bid; it < 2080; it += G) scan_item<1>(P, lds, l, it); GSYNC(); phase_scan2(P); GSYNC(); }
            if (PROBE == 4) { const int tidh = otid(); Hy1Regs hc; for (int it = bid; it < 2080; it += G) { hy1_load(P, it, tidh, hc); hy1_weights(P, lds, l, it & 7, tidh); hy1_item(P, lds, l, it, tidh, hc); } GSYNC(); for (int c = bid; c < 512; c += G) hy2_item(P, lds, c); GSYNC(); }
            for (int rp_ = 0; rp_ < ((PROBE == 11 || PROBE == 13) ? 2 : 1); ++rp_)
            { if (rp_ == 0 || PROBE == 13) for (int k = 0;; ++k) { const int it = hy_pick(last ? 0 : 1, G, bid, k); if (it < 0) break; hy3_item(P, lds, it, last); }
              if (rp_ == 0 || PROBE == 11) for (int it = bid; it < 2080; it += G) { if (last && (it % (NBLK * 4)) < 16) continue;
                  scan_item<3>(P, lds, l, it); } }
            GSYNC();
            { pg8::Gemm g{(const bf16_t*)(P->ws + O_PHY), WT + WT_BR, 1536, 512, 512, 512, (long)1024 * 512}; pg8::Sched S; S.init(last ? 64 : 65, 4, G, bid, last ? 1 : 0, 3);
              pg8::EpiMerge E{(const bf16_t*)(P->ws + O_GATES), (bf16_t*)(P->ws + O_H)};
              RPT(2) if (PON(13)) pg8::gemm_phase(lds, g, S, E); }
            if (b == 0) phase_modulate(P, l, 0, RB, 2 * RB, (bf16_t*)(P->ws + O_U), first);
            if (l == 0 && b == 1 && G == 256 && bid >= 4) phase_wconv(P, lds, 1, 0, WT_T_IN, bid - 4, 252);
            GSYNC();
            { pg8::Gemm g{(const bf16_t*)(P->ws + O_H), WT + WT_OUT, 1024, 1024, 1024, 0, 0}; pg8::Sched S; S.init(last ? 64 : 65, 4, G, bid, last ? 1 : 0, 1);
              pg8::EpiRes E{first ? P->in[I_X] : P->out, P->out, first ? P->in[I_CTX] : (const float*)(P->ws + O_XCTX), (float*)(P->ws + O_XCTX), (const float*)(P->ws + O_MOD) + (size_t)l * 3 * 6144, 2048, b * RB};
              if (PON(14)) pg8::gemm_phase(lds, g, S, E); }
            if (l == 0 && b == 1 && G == 256 && bid >= 4) phase_wconv(P, lds, 1, WT_T_IN, WT_T_BR, bid - 4, 252);
            GSYNC();
        }
        RPT(8) if (PON(15)) phase_modulate(P, l, 1, 0, RT, (bf16_t*)(P->ws + O_H2), false);
        GSYNC();
        { pg8::Gemm g{(const bf16_t*)(P->ws + O_H2), WT + WT_UP, 1024, 1024, 1024, 0, 0}; pg8::Sched S; if (last) S.init(128, 22, G, bid, 0, 1, 1); else S.init(RT / 256, 22, G, bid, 0, 1);
          pg8::EpiUp E{(bf16_t*)(P->ws + O_A), (bf16_t*)(P->ws + O_V)};
          RPT(2) if (PON(16)) pg8::gemm_phase(lds, g, S, E); }
        if (l == 0 && G == 256 && bid >= 44) phase_wconv(P, lds, 1, WT_T_BR, WT_T_OUT, bid - 44, 212);
        GSYNC();
        if (PON(17)) phase_convglu(P, l);
        GSYNC();
        if (PROBE == 6) { { pg8::Gemm g{(const bf16_t*)(P->ws + O_H2), WT + WT_UP, 1024, 1024, 1024, 0, 0}; pg8::Sched S; S.init(RT / 256, 22, G, bid, 0, 1); pg8::EpiUp E{(bf16_t*)(P->ws + O_A), (bf16_t*)(P->ws + O_V)}; pg8::gemm_phase(lds, g, S, E); } GSYNC(); phase_convglu(P, l); GSYNC(); }
        { pg8::Gemm g{(const bf16_t*)(P->ws + O_V), WT + WT_DN, DFF, DFF, DFF, 0, 0}; pg8::Sched S; if (last) S.init(128, 4, G, bid, 0, 1, 1); else S.init(RT / 256, 4, G, bid, 0, 1);
          pg8::EpiRes E{P->out, P->out, (const float*)(P->ws + O_XCTX), (float*)(P->ws + O_XCTX), (const float*)(P->ws + O_MOD) + (size_t)l * 3 * 6144, 5120, 0};
          if (PON(18)) pg8::gemm_phase(lds, g, S, E); }
        if (l == 0 && G == 256 && bid >= 8) { phase_filt1(P, lds, 1, bid - 8, 248); phase_wconv(P, lds, 1, WT_T_OUT, WT_T_UP, bid - 8, 248); }
        GSYNC();
    }
    if (PON(19)) phase_final(P);
#undef P
#undef WT
}

extern "C" void kernel_launch(void* const* d_in, const int* in_sizes, int n_in, void* d_out, int out_size, void* d_ws, size_t ws_size, hipStream_t stream) {
    static int grid_blocks = 0;
    if (grid_blocks == 0) {
        if (n_in != N_INPUTS || ws_size < WS_NEED) { fprintf(stderr, "kernel_launch: unexpected inputs (%d) or workspace (%zu < %zu)\n", n_in, ws_size, (size_t)WS_NEED); grid_blocks = -1; return; }
        int dev = 0, cus = 0, per_cu = 0;
        hipGetDevice(&dev); hipDeviceGetAttribute(&cus, hipDeviceAttributeMultiprocessorCount, dev);
        if (hipFuncSetAttribute((const void*)fwd_megakernel, hipFuncAttributeMaxDynamicSharedMemorySize, LDS_BYTES) != hipSuccess) { fprintf(stderr, "kernel_launch: hipFuncSetAttribute failed\n"); }
        hipOccupancyMaxActiveBlocksPerMultiprocessor(&per_cu, (const void*)fwd_megakernel, NT, LDS_BYTES);
        if (per_cu < 1) { fprintf(stderr, "kernel_launch: occupancy query reports %d blocks per CU\n", per_cu); per_cu = 1; }
        (void)hipGetLastError();
        grid_blocks = cus;
    }
    if (grid_blocks < 0) return;
    if (hipMemsetAsync(d_ws, 0, BAR_BYTES, stream) != hipSuccess) { fprintf(stderr, "kernel_launch: memset failed\n"); return; }
    Params p{};
    for (int i = 0; i < N_INPUTS; ++i) p.in[i] = (const float*)d_in[i];
    p.out = (float*)d_out; p.ws = (unsigned char*)d_ws;
    void* args[] = {&p};
    hipError_t e = hipLaunchCooperativeKernel((const void*)fwd_megakernel, dim3(grid_blocks), dim3(NT), args, LDS_BYTES, stream);
    if (e != hipSuccess) fprintf(stderr, "cooperative launch failed: %s (grid %d)\n", hipGetErrorString(e), grid_blocks);
}
#endif
```

```cpp
#include <hip/hip_runtime.h>
#include <hip/hip_cooperative_groups.h>
#include <cstdio>
#include <cstdint>
#include <cmath>
namespace cg = cooperative_groups;

#define LAS __attribute__((address_space(3)))
#define HD __host__ __device__ __forceinline__
#define DI __device__ __forceinline__
typedef unsigned short bf16_t;
typedef short bf16x8 __attribute__((ext_vector_type(8)));
typedef float f32x4 __attribute__((ext_vector_type(4)));
typedef float f32x2 __attribute__((ext_vector_type(2)));
typedef unsigned u32x4 __attribute__((ext_vector_type(4)));
typedef unsigned u32x2 __attribute__((ext_vector_type(2)));

constexpr int D = 1024, NB = 2, SEQ = 16384, CTX = 256, RB = CTX + SEQ, RT = NB * RB;
constexpr int NIN = 7936, DFF = 2816;
constexpr int NBLK = RB / 64;
constexpr int FM = 16384;
constexpr int NT = 512;
constexpr int LDS_BYTES = 155648;
#ifndef PMASK
#define PMASK 0xFFFFFFFFu
#endif
#define PON(k) ((PMASK >> (k)) & 1u)
#ifndef PROBE
#define PROBE 0
#endif
#define RPT(p) for (int rp_ = 0; rp_ < (PROBE == (p) ? 2 : 1); ++rp_)

enum { I_X = 0, I_C, I_CTX, I_CCTX, I_ADAW, I_ADAB, I_N1G, I_WIN, I_WA2, I_BA, I_SHW, I_SHB, I_HW1, I_HB1, I_HW2, I_HB2, I_HW3, I_HFREQ, I_HBIAS,
       I_WBR, I_WOUT, I_N2G, I_WUP, I_FCW, I_FCB, I_WDN, I_FING, N_INPUTS };

struct Params { const float* in[N_INPUTS]; float* out; unsigned char* ws; };


typedef const Params __attribute__((address_space(4)))* PP4;
DI PP4 getP() { PP4 p = (PP4)__builtin_amdgcn_kernarg_segment_ptr(); asm volatile("" : "+s"(p)); return p; }
DI int otid() { int t = threadIdx.x; asm volatile("" : "+v"(t)); return t; }
DI int obid() { int t = blockIdx.x; asm volatile("" : "+s"(t)); return t; }
DI int ogrid() { int t = gridDim.x; asm volatile("" : "+s"(t)); return t; }

constexpr size_t al256(size_t x) { return (x + 255) & ~(size_t)255; }
constexpr size_t O_BAR = 0;
constexpr size_t BAR_BYTES = 16384;
constexpr size_t O_MOD = BAR_BYTES;
constexpr size_t O_XCTX = al256(O_MOD + (size_t)2 * 3 * 6144 * 4);
constexpr size_t O_HDN = al256(O_XCTX + (size_t)2 * 256 * 1024 * 4);
constexpr size_t O_HFC = al256(O_HDN + (size_t)16640 * 64 * 4);
constexpr size_t O_ABUF = al256(O_HFC + (size_t)2 * 256 * 512 * 4);
constexpr size_t O_LR = al256(O_ABUF + (size_t)16 * 260 * 64 * 4);
constexpr size_t O_ZCTX = al256(O_LR + (size_t)16640 * 32 * 4);
constexpr size_t O_WT = al256(O_ZCTX + (size_t)256 * 512 * 4);
constexpr size_t WT_IN = 0, WT_BR = WT_IN + (size_t)NIN * 1024, WT_OUT = WT_BR + (size_t)3 * 1024 * 512, WT_UP = WT_OUT + (size_t)1024 * 1024,
                 WT_DN = WT_UP + (size_t)5632 * 1024, WT_END = WT_DN + (size_t)1024 * 2816;
constexpr size_t O_BIG = al256(O_WT + WT_END * 2);
constexpr size_t O_K = O_BIG;
constexpr size_t O_H = al256(O_K + (size_t)512 * 16384 * 8);
constexpr size_t O_PRET = al256(O_H + (size_t)RB * 1024 * 2);
constexpr size_t O_PGLA = al256(O_PRET + (size_t)RB * 1536 * 2);
constexpr size_t O_PHY = al256(O_PGLA + (size_t)RB * 1536 * 2);
constexpr size_t O_GATES = al256(O_PHY + (size_t)RB * 1536 * 2);
constexpr size_t O_U = al256(O_GATES + (size_t)RB * 3072 * 2);
constexpr size_t O_ZT = al256(O_U + (size_t)16 * 260 * 8192 * 2);
constexpr size_t O_X0C = al256(O_ZT + (size_t)512 * 16384 * 2);
constexpr size_t O_MIX_END = al256(O_X0C + (size_t)RB * 512 * 2);
constexpr size_t O_H2 = O_BIG;
constexpr size_t O_A = al256(O_H2 + (size_t)RT * 1024 * 2);
constexpr size_t O_V = al256(O_A + (size_t)RT * DFF * 2);
constexpr size_t O_FFN_END = al256(O_V + (size_t)RT * DFF * 2);
constexpr size_t WS_NEED = O_MIX_END > O_FFN_END ? O_MIX_END : O_FFN_END;
static_assert(WS_NEED <= (size_t)512 * 1024 * 1024, "workspace over 512 MiB");

HD float bf2f(bf16_t v) { union { unsigned u; float f; } c; c.u = ((unsigned)v) << 16; return c.f; }
HD unsigned pk2(float lo, float hi) {
#if defined(__HIP_DEVICE_COMPILE__)
    unsigned r; asm volatile("v_cvt_pk_bf16_f32 %0, %1, %2" : "=v"(r) : "v"(lo), "v"(hi)); return r;
#else
    union { unsigned u; float f; } a, b; a.f = lo; b.f = hi; unsigned x = a.u, y = b.u; x += 0x7FFFu + ((x >> 16) & 1u); y += 0x7FFFu + ((y >> 16) & 1u); return (x >> 16) | (y & 0xffff0000u);
#endif
}
HD bf16_t f2bf(float f) { return (bf16_t)(pk2(f, 0.f) & 0xffffu); }
DI float wave_sum(float v) {
#pragma unroll
    for (int o = 1; o < 64; o <<= 1) v += __shfl_xor(v, o);
    return v;
}
DI float silu_f(float x) { return x * __builtin_amdgcn_rcpf(1.0f + __expf(-x)); }
DI float sigmoid_f(float x) { return __builtin_amdgcn_rcpf(1.0f + __expf(-x)); }


#define XB_TMO      128
#define XB_XCNT(j)  (256  + 64 * (j))
#define XB_XSUB(j)  (1280 + 64 * (j))
#define XB_XGEN(j)  (2304 + 64 * (j))
#define XB_TOP      3328
#define XB_TOPGEN   3392
#define XCD_BAR_WORDS 3456
#define XB_SPIN_CAP (1u << 20)
DI unsigned xb_ld(unsigned* p) { return __hip_atomic_load(p, __ATOMIC_RELAXED, __HIP_MEMORY_SCOPE_AGENT); }
DI unsigned xb_add(unsigned* p, unsigned v) { return __hip_atomic_fetch_add(p, v, __ATOMIC_RELAXED, __HIP_MEMORY_SCOPE_AGENT); }
DI unsigned xb_xcc_id() { return (unsigned)__builtin_amdgcn_s_getreg((3 << 11) | 20) & 0xFu; }
#define XB_SPIN(cond, bar) do { unsigned _sp = 0; while (cond) { __builtin_amdgcn_s_sleep(1); \
    if ((++_sp & 255u) == 0u) { if (xb_ld(&(bar)[XB_TMO])) break; if (_sp > XB_SPIN_CAP) { atomicAdd(&(bar)[XB_TMO], 1u); break; } } } } while (0)
struct XcdBarrier { unsigned* bar; unsigned x; volatile LAS unsigned* st; };
DI XcdBarrier xcd_barrier_post(unsigned* bar, volatile LAS unsigned* st) {
    XcdBarrier b; b.bar = bar; b.x = xb_xcc_id(); b.st = st;
    if (threadIdx.x == 0) (void)xb_add(&bar[XB_XCNT(b.x)], 1u);
    return b;
}
DI void xcd_barrier_complete(unsigned* bar, unsigned x, unsigned& nloc, unsigned& nx) {
    const unsigned G = gridDim.x * gridDim.y * gridDim.z;
    unsigned sum, cnt, mine, sp = 0u;
    for (;;) {
        sum = 0u; cnt = 0u; mine = 0u;
#pragma unroll
        for (unsigned j = 0; j < 16; ++j) { const unsigned c = xb_ld(&bar[XB_XCNT(j)]); sum += c; cnt += (c > 0u) ? 1u : 0u; mine = (j == x) ? c : mine; }
        if (sum == G) break;
        __builtin_amdgcn_s_sleep(1);
        if ((++sp & 255u) == 0u) { if (xb_ld(&bar[XB_TMO])) break; if (sp > XB_SPIN_CAP) { atomicAdd(&bar[XB_TMO], 1u); break; } }
    }
    nloc = mine > 0u ? mine : 1u; nx = cnt > 0u ? cnt : 1u;
}
DI void xcd_barrier(const XcdBarrier& b) {
    asm volatile("s_waitcnt vmcnt(0)" ::: "memory");
    __syncthreads();
    if (threadIdx.x == 0) {
        unsigned* bar = b.bar;
        __builtin_amdgcn_s_waitcnt(0);
        unsigned nloc = b.st[0], nx = b.st[1];
        if (nloc == 0u) { xcd_barrier_complete(bar, b.x, nloc, nx); b.st[0] = nloc; b.st[1] = nx; }
        const unsigned old = xb_add(&bar[XB_XSUB(b.x)], 1u);
        const unsigned gen = old / nloc;
        if (old + 1u == (gen + 1u) * nloc) {
            __builtin_amdgcn_fence(__ATOMIC_RELEASE, "agent");
            asm volatile("s_waitcnt vmcnt(0)" ::: "memory");
            const unsigned og = xb_add(&bar[XB_TOP], 1u);
            const unsigned tg = og / nx;
            if (og + 1u == (tg + 1u) * nx) xb_add(&bar[XB_TOPGEN], 1u);
            else XB_SPIN(xb_ld(&bar[XB_TOPGEN]) == tg, bar);
            __builtin_amdgcn_fence(__ATOMIC_ACQUIRE, "agent");
            xb_add(&bar[XB_XGEN(b.x)], 1u);
            asm volatile("s_waitcnt vmcnt(0)" ::: "memory");
        } else {
            XB_SPIN(xb_ld(&bar[XB_XGEN(b.x)]) == gen, bar);
            __builtin_amdgcn_fence(__ATOMIC_ACQUIRE, "agent");
            asm volatile("s_waitcnt vmcnt(0)" ::: "memory");
        }
    }
    __syncthreads();
}

namespace pg8 {
constexpr int BM = 256, BK = 64, HALF = 128, HTB = HALF * BK * 2, STAGE_BYTES = 8 * HTB, NXCD = 8, WGM = 4;
HD int lds_byte(int r, int c) { const int st = (r >> 4) * 2 + (c >> 5), rr = r & 15, cc = c & 31, ob = rr * 64 + cc * 2; return st * 1024 + (ob ^ (((ob >> 9) & 1) << 5)); }
HD void stage_rc(int b, int& R, int& C) { const int st = b / 1024, sb = b % 1024, swz = sb ^ (((sb >> 9) & 1) << 5); R = (st >> 1) * 16 + swz / 64; C = (st & 1) * 32 + (swz % 64) / 2; }
HD int perm32(int rho) { const int n = rho >> 4, i = rho & 15; return 8 * (i >> 2) + 4 * n + (i & 3); }

struct Unit { int pm, pn, rep; };
struct Gemm { const bf16_t* A; const bf16_t* Bt; int lda, ldb, K; long arep, brep; };
struct Sched {
    int nM, nN, nwg, G, c, pm0, nrep, jmode;
    DI void init(int nM_, int nN_, int G_, int c_, int pm0_, int nrep_, int jmode_ = 0) { nM = nM_; nN = nN_; nwg = nM * nN; G = G_; c = c_; pm0 = pm0_; nrep = nrep_; jmode = jmode_; }
    DI bool next(int i, Unit& u) const {
        int it = i, rep = 0;
        if (nrep == 3) { it = i / 3; rep = i - it * 3; }
        const long L = (long)it * G + c; if (L >= nwg) return false;
        int wgid = (int)L; { const int q = nwg / NXCD, r = nwg % NXCD, xcd = wgid % NXCD, off = wgid / NXCD; wgid = (xcd < r ? xcd * (q + 1) : r * (q + 1) + (xcd - r) * q) + off; }
        const int nig = WGM * nN, gid = wgid / nig, fm = gid * WGM, gsz = (nM - fm) < WGM ? (nM - fm) : WGM;
        int pm = fm + ((wgid % nig) % gsz); if (jmode) pm += 1 + (pm >= 64 ? 1 : 0);
        u.pm = pm0 + pm; u.pn = (wgid % nig) / gsz; u.rep = rep; return true;
    }
};
DI unsigned cvt_pk_bf16(float lo, float hi) { unsigned r; asm volatile("v_cvt_pk_bf16_f32 %0, %1, %2" : "=v"(r) : "v"(lo), "v"(hi)); return r; }

template <class Epi>
DI void gemm_phase(LAS unsigned char* lds, const Gemm g, const Sched& S, const Epi& E) {
    const int tid = otid(), wid = __builtin_amdgcn_readfirstlane(tid >> 6), lane = tid & 63, wr = wid >> 2, wc = wid & 3, fr = lane & 15, fq = lane >> 4;
    const int K = g.K, nt = K / BK;
    unsigned voffA[2], voffB[2];
#pragma unroll
    for (int i = 0; i < 2; ++i) { int R, C; stage_rc(tid * 16 + i * 8192, R, C); const int Rb = Epi::PERM ? ((R & ~31) + perm32(R & 31)) : R;
        voffA[i] = (unsigned)(R * g.lda + C) * 2u; voffB[i] = (unsigned)(Rb * g.ldb + C) * 2u; }
    const size_t kstep = (size_t)(BK * 2);
    const size_t hstepA = (size_t)HALF * g.lda * 2, hstepB = (size_t)HALF * g.ldb * 2;
    const size_t tstepA = 2 * hstepA, tstepB = 2 * hstepB;
    const unsigned ldsw = (unsigned)wid * 1024u;
    const int aoff = lds_byte(wr * 64 + fr, fq * 8), boff = lds_byte(wc * 32 + fr, fq * 8);
#define PG8_SA(b, h) (((b) * 2 + (h)) * HTB)
#define PG8_SB(b, h) ((4 + (b) * 2 + (h)) * HTB)
#define PG8_STAGE(bufoff, gbase, voff) do { _Pragma("unroll") for (int _i = 0; _i < 2; ++_i) \
        __builtin_amdgcn_global_load_lds((const unsigned*)((const char*)(gbase) + (voff)[_i]), (LAS unsigned*)(lds + (bufoff) + ldsw + _i * 8192), 16, 0, 0); } while (0)
#define PG8_LDA(dst, b, h) do { _Pragma("unroll") for (int m = 0; m < 4; ++m) _Pragma("unroll") for (int k = 0; k < 2; ++k) dst[m][k] = *(const LAS bf16x8*)(lds + PG8_SA(b, h) + aoff + m * 2048 + k * 1024); } while (0)
#define PG8_LDB(dst, b, h) do { _Pragma("unroll") for (int n = 0; n < 2; ++n) _Pragma("unroll") for (int k = 0; k < 2; ++k) dst[n][k] = *(const LAS bf16x8*)(lds + PG8_SB(b, h) + boff + n * 2048 + k * 1024); } while (0)
#define PG8_MMA(ai, bj, At, Bt) do { __builtin_amdgcn_s_setprio(1); _Pragma("unroll") for (int m = 0; m < 4; ++m) _Pragma("unroll") for (int n = 0; n < 2; ++n) _Pragma("unroll") for (int k = 0; k < 2; ++k) \
        acc[ai][bj][m][n] = __builtin_amdgcn_mfma_f32_16x16x32_bf16(Bt[n][k], At[m][k], acc[ai][bj][m][n], 0, 0, 0); __builtin_amdgcn_s_setprio(0); } while (0)
#define PG8_WAIT_V(n) asm volatile("s_waitcnt vmcnt(" #n ")" ::: "memory")
#define PG8_WAIT_L(n) asm volatile("s_waitcnt lgkmcnt(" #n ")" ::: "memory")
#define PG8_BAR __builtin_amdgcn_s_barrier()
#define PG8_SCHED __builtin_amdgcn_sched_barrier(0)
    Unit cur, nxt; int ui = 0;
    if (!S.next(0, cur)) return;
    f32x4 acc[2][2][4][2];
#pragma unroll
    for (int a = 0; a < 2; ++a)
#pragma unroll
        for (int b = 0; b < 2; ++b)
#pragma unroll
            for (int m = 0; m < 4; ++m)
#pragma unroll
                for (int n = 0; n < 2; ++n) acc[a][b][m][n] = (f32x4){0.f, 0.f, 0.f, 0.f};
    bf16x8 At[4][2], B0[2][2], B1[2][2];
    const char* cA = (const char*)g.A + (size_t)cur.pm * tstepA + (size_t)cur.rep * g.arep * 2;
    const char* cB = (const char*)g.Bt + (size_t)cur.pn * tstepB + (size_t)cur.rep * g.brep * 2;
    PG8_STAGE(PG8_SB(0, 0), cB, voffB); PG8_STAGE(PG8_SB(0, 1), cB + hstepB, voffB); PG8_STAGE(PG8_SA(0, 0), cA, voffA); PG8_STAGE(PG8_SA(0, 1), cA + hstepA, voffA);
    if (wr == 1) PG8_BAR;
    PG8_WAIT_V(2); PG8_BAR;
    PG8_STAGE(PG8_SB(1, 0), cB + kstep, voffB); PG8_STAGE(PG8_SA(1, 0), cA + kstep, voffA); PG8_STAGE(PG8_SB(1, 1), cB + hstepB + kstep, voffB);
    PG8_WAIT_V(6); PG8_BAR;
    for (;;) {
        const bool has_next = S.next(ui + 1, nxt);
        const char* nA = has_next ? (const char*)g.A + (size_t)nxt.pm * tstepA + (size_t)nxt.rep * g.arep * 2 : cA;
        const char* nB = has_next ? (const char*)g.Bt + (size_t)nxt.pn * tstepB + (size_t)nxt.rep * g.brep * 2 : cB;
        for (int t = 0; t < nt; t += 2) {
            const bool last = (t == nt - 2);
            const char* a1 = cA + (size_t)(t + 1) * kstep;
            const char* a2 = last ? nA : cA + (size_t)(t + 2) * kstep; const char* b2 = last ? nB : cB + (size_t)(t + 2) * kstep;
            const char* a3 = a2 + kstep; const char* b3 = b2 + kstep;
            PG8_LDB(B0, 0, 0); PG8_LDB(B1, 0, 1); PG8_SCHED; PG8_LDA(At, 0, 0); PG8_STAGE(PG8_SA(1, 1), a1 + hstepA, voffA);
            PG8_WAIT_V(8); PG8_WAIT_L(0); PG8_BAR; PG8_MMA(0, 0, At, B0); PG8_MMA(0, 1, At, B1); PG8_BAR; PG8_SCHED;
            PG8_LDA(At, 0, 1); PG8_STAGE(PG8_SB(0, 0), b2, voffB); PG8_STAGE(PG8_SB(0, 1), b2 + hstepB, voffB); PG8_STAGE(PG8_SA(0, 0), a2, voffA);
            PG8_WAIT_V(8); PG8_WAIT_L(0); PG8_BAR; PG8_MMA(1, 0, At, B0); PG8_MMA(1, 1, At, B1); PG8_BAR; PG8_SCHED;
            PG8_LDB(B0, 1, 0); PG8_LDB(B1, 1, 1); PG8_SCHED; PG8_LDA(At, 1, 0); PG8_STAGE(PG8_SA(0, 1), a2 + hstepA, voffA);
            PG8_WAIT_V(8); PG8_WAIT_L(0); PG8_BAR; PG8_MMA(0, 0, At, B0); PG8_MMA(0, 1, At, B1); PG8_BAR; PG8_SCHED;
            PG8_LDA(At, 1, 1); PG8_STAGE(PG8_SB(1, 0), b3, voffB); PG8_STAGE(PG8_SB(1, 1), b3 + hstepB, voffB); PG8_STAGE(PG8_SA(1, 0), a3, voffA);
            PG8_WAIT_V(8); PG8_WAIT_L(0); PG8_BAR; PG8_MMA(1, 0, At, B0); PG8_MMA(1, 1, At, B1); PG8_BAR; PG8_SCHED;
        }
        if (wr == 0) PG8_BAR;
        E(acc, cur, wr, wc, fr, fq);
        if (!has_next) break;
#pragma unroll
        for (int a = 0; a < 2; ++a)
#pragma unroll
            for (int b = 0; b < 2; ++b)
#pragma unroll
                for (int m = 0; m < 4; ++m)
#pragma unroll
                    for (int n = 0; n < 2; ++n) acc[a][b][m][n] = (f32x4){0.f, 0.f, 0.f, 0.f};
        cur = nxt; cA = nA; cB = nB; ++ui;
        if (wr == 1) PG8_BAR;
    }
    PG8_WAIT_V(0);
    PG8_BAR;
#undef PG8_SA
#undef PG8_SB
#undef PG8_STAGE
#undef PG8_LDA
#undef PG8_LDB
#undef PG8_MMA
#undef PG8_WAIT_V
#undef PG8_WAIT_L
#undef PG8_BAR
#undef PG8_SCHED
}

struct EpiWin {
    static constexpr bool PERM = true;
    bf16_t *pret, *pgla, *phy, *gates; float* lr;
    DI void operator()(const f32x4 (&acc)[2][2][4][2], const Unit& u, int wr, int wc, int fr, int fq) const {
        const int row0 = u.pm * BM + wr * 64 + fr; const int pn = u.pn;
        if (pn < 30) {
            bf16_t* base; int ldc, colt; bool sig = false;
            if (pn < 6) { base = pret; ldc = 1536; colt = pn * 256; }
            else if (pn < 12) { base = pgla; ldc = 1536; colt = (pn - 6) * 256; }
            else if (pn < 18) { base = phy; ldc = 1536; colt = (pn - 12) * 256; }
            else { base = gates; ldc = 3072; colt = (pn - 18) * 256; sig = true; }
            const int col0 = colt + wc * 32 + 8 * fq;
#pragma unroll
            for (int ai = 0; ai < 2; ++ai)
#pragma unroll
                for (int m = 0; m < 4; ++m) { bf16_t* rowp = base + (size_t)(row0 + ai * HALF + m * 16) * ldc + col0;
#pragma unroll
                    for (int bj = 0; bj < 2; ++bj) { f32x4 v0 = acc[ai][bj][m][0], v1 = acc[ai][bj][m][1];
                        if (sig) {
#pragma unroll
                            for (int j = 0; j < 4; ++j) { v0[j] = sigmoid_f(v0[j]); v1[j] = sigmoid_f(v1[j]); } }
                        u32x4 w; w.x = cvt_pk_bf16(v0[0], v0[1]); w.y = cvt_pk_bf16(v0[2], v0[3]); w.z = cvt_pk_bf16(v1[0], v1[1]); w.w = cvt_pk_bf16(v1[2], v1[3]);
                        __builtin_nontemporal_store(w, (u32x4*)(rowp + bj * HALF)); } }
        } else if (wc == 0) {
#pragma unroll
            for (int ai = 0; ai < 2; ++ai)
#pragma unroll
                for (int m = 0; m < 4; ++m) { float* rowp = lr + (size_t)(row0 + ai * HALF + m * 16) * 32 + 8 * fq;
                    *(f32x4*)(rowp) = acc[ai][0][m][0]; *(f32x4*)(rowp + 4) = acc[ai][0][m][1]; }
        }
    }
};
struct EpiUp {
    static constexpr bool PERM = true;
    bf16_t *a, *v;
    DI void operator()(const f32x4 (&acc)[2][2][4][2], const Unit& u, int wr, int wc, int fr, int fq) const {
        const int row0 = u.pm * BM + wr * 64 + fr;
        bf16_t* base = u.pn < 11 ? a : v; const int colt = (u.pn < 11 ? u.pn : u.pn - 11) * 256;
        const int col0 = colt + wc * 32 + 8 * fq;
#pragma unroll
        for (int ai = 0; ai < 2; ++ai)
#pragma unroll
            for (int m = 0; m < 4; ++m) { bf16_t* rowp = base + (size_t)(row0 + ai * HALF + m * 16) * DFF + col0;
#pragma unroll
                for (int bj = 0; bj < 2; ++bj) { const f32x4 v0 = acc[ai][bj][m][0], v1 = acc[ai][bj][m][1];
                    u32x4 w; w.x = cvt_pk_bf16(v0[0], v0[1]); w.y = cvt_pk_bf16(v0[2], v0[3]); w.z = cvt_pk_bf16(v1[0], v1[1]); w.w = cvt_pk_bf16(v1[2], v1[3]);
                    __builtin_nontemporal_store(w, (u32x4*)(rowp + bj * HALF)); } }
    }
};
struct EpiMerge {
    static constexpr bool PERM = true;
    const bf16_t* gates; bf16_t* mixed;
    DI void operator()(const f32x4 (&acc)[2][2][4][2], const Unit& u, int wr, int wc, int fr, int fq) const {
        const int row0 = u.pm * BM + wr * 64 + fr; const int col0 = u.pn * 256 + wc * 32 + 8 * fq;
#pragma unroll
        for (int ai = 0; ai < 2; ++ai)
#pragma unroll
            for (int m = 0; m < 4; ++m) { const size_t row = (size_t)(row0 + ai * HALF + m * 16);
#pragma unroll
                for (int bj = 0; bj < 2; ++bj) {
                    const u32x4 gv = *(const u32x4*)(gates + row * 3072 + u.rep * 1024 + col0 + bj * HALF);
                    bf16_t* mp = mixed + row * 1024 + col0 + bj * HALF;
                    u32x4 pv = (u32x4){0u, 0u, 0u, 0u}; if (u.rep > 0) pv = *(const u32x4*)mp;
                    const f32x4 v0 = acc[ai][bj][m][0], v1 = acc[ai][bj][m][1];
                    float o[8];
#pragma unroll
                    for (int j = 0; j < 4; ++j) { const unsigned gw = gv[j], pw = pv[j]; const float a0 = (j < 2) ? v0[2 * j] : v1[2 * j - 4], a1 = (j < 2) ? v0[2 * j + 1] : v1[2 * j - 3];
                        o[2 * j] = __uint_as_float(pw << 16) + __uint_as_float(gw << 16) * a0; o[2 * j + 1] = __uint_as_float(pw & 0xffff0000u) + __uint_as_float(gw & 0xffff0000u) * a1; }
                    u32x4 w; w.x = cvt_pk_bf16(o[0], o[1]); w.y = cvt_pk_bf16(o[2], o[3]); w.z = cvt_pk_bf16(o[4], o[5]); w.w = cvt_pk_bf16(o[6], o[7]);
                    *(u32x4*)mp = w; } }
    }
};
struct EpiRes {
    static constexpr bool PERM = false;
    const float* src_lat; float* dst_lat; const float* src_ctx; float* dst_ctx; const float* mod; int goff; int rowbase;
    DI void operator()(const f32x4 (&acc)[2][2][4][2], const Unit& u, int wr, int wc, int fr, int fq) const {
        const int R0 = rowbase + u.pm * BM; const int b = R0 / RB; const int rr0 = R0 - b * RB; const bool isctx = rr0 < CTX;
        const float* sp = isctx ? src_ctx + (size_t)b * CTX * D : src_lat + (size_t)b * SEQ * D;
        float* dp = isctx ? dst_ctx + (size_t)b * CTX * D : dst_lat + (size_t)b * SEQ * D;
        const int lr0 = (isctx ? rr0 : rr0 - CTX) + wr * 64 + fr; const int col0 = u.pn * BM + wc * 32 + 4 * fq;
        const float* gp = mod + (isctx ? 2 : b) * 6144 + goff + col0;
        f32x4 gv[2][2];
#pragma unroll
        for (int bj = 0; bj < 2; ++bj)
#pragma unroll
            for (int n = 0; n < 2; ++n) gv[bj][n] = *(const f32x4*)(gp + bj * HALF + n * 16);
#pragma unroll
        for (int ai = 0; ai < 2; ++ai)
#pragma unroll
            for (int m = 0; m < 4; ++m) { const size_t off = (size_t)(lr0 + ai * HALF + m * 16) * D + col0;
#pragma unroll
                for (int bj = 0; bj < 2; ++bj)
#pragma unroll
                    for (int n = 0; n < 2; ++n) { const f32x4 xs = *(const f32x4*)(sp + off + bj * HALF + n * 16);
                        *(f32x4*)(dp + off + bj * HALF + n * 16) = xs + gv[bj][n] * acc[ai][bj][m][n]; }
                asm volatile("" ::: "memory"); }
    }
};
}

typedef float cf __attribute__((ext_vector_type(2)));
HD cf cmul(cf a, cf b) { const cf bs = {-b.y, b.x}; return a.xx * b + a.yy * bs; }
HD cf cadd(cf a, cf b) { return a + b; }
HD cf csub(cf a, cf b) { return a - b; }
HD cf cconj(cf a) { cf r; r.x = a.x; r.y = -a.y; return r; }
HD void sincos_turns(float fr, float& s, float& c) {
#if defined(__HIP_DEVICE_COMPILE__)
    s = __builtin_amdgcn_sinf(fr); c = __builtin_amdgcn_cosf(fr);
#else
    s = (float)sin(6.283185307179586 * (double)fr); c = (float)cos(6.283185307179586 * (double)fr);
#endif
}
HD int rev4_14(int x) {
#if defined(__HIP_DEVICE_COMPILE__)
    unsigned v = __builtin_bitreverse32((unsigned)x) >> 18;
#else
    unsigned v = (unsigned)x;
    v = ((v >> 1) & 0x55555555u) | ((v & 0x55555555u) << 1); v = ((v >> 2) & 0x33333333u) | ((v & 0x33333333u) << 2); v = ((v >> 4) & 0x0F0F0F0Fu) | ((v & 0x0F0F0F0Fu) << 4);
    v = ((v >> 8) & 0x00FF00FFu) | ((v & 0x00FF00FFu) << 8); v = (v >> 16) | (v << 16);
    v >>= 18;
#endif
    return (int)(((v & 0x1555u) << 1) | ((v >> 1) & 0x1555u));
}
HD void bfly_fwd(cf& a0, cf& a1, cf& a2, cf& a3) {
    const cf t0 = a0 + a2, t1 = a0 - a2, t2 = a1 + a3, t3 = a1 - a3; const cf r = {t3.y, -t3.x};
    a0 = t0 + t2; a2 = t0 - t2; a1 = t1 + r; a3 = t1 - r;
}
HD void bfly_inv(cf& a0, cf& a1, cf& a2, cf& a3) {
    const cf t0 = a0 + a2, t1 = a0 - a2, t2 = a1 + a3, t3 = a1 - a3; const cf r = {t3.y, -t3.x};
    a0 = t0 + t2; a2 = t0 - t2; a1 = t1 - r; a3 = t1 + r;
}
HD int PX(int p) { return p + (p >> 4); }
constexpr int FMP = FM + FM / 16;
template <class P> HD void fft_fwd_stage(P x, int s, int tid, int nth) {
    const int lgq = 12 - 2 * s, q = 1 << lgq, n = q * 4;
#pragma unroll 4
    for (int b = tid; b < 4096; b += nth) {
        const int blk = b >> lgq, j = b & (q - 1), base = blk * n + j;
        cf a0 = x[PX(base)], a1 = x[PX(base + q)], a2 = x[PX(base + 2 * q)], a3 = x[PX(base + 3 * q)];
        bfly_fwd(a0, a1, a2, a3);
        float sn, cs; sincos_turns((float)(j << (2 * s)) * (1.0f / 16384.0f), sn, cs);
        cf w; w.x = cs; w.y = -sn; const cf w2 = cmul(w, w), w3 = cmul(w2, w);
        x[PX(base)] = a0; x[PX(base + q)] = cmul(a1, w); x[PX(base + 2 * q)] = cmul(a2, w2); x[PX(base + 3 * q)] = cmul(a3, w3);
    }
}
template <class P> HD void fft_inv_stage(P x, int s, int tid, int nth) {
    const int lgq = 12 - 2 * s, q = 1 << lgq, n = q * 4;
#pragma unroll 4
    for (int b = tid; b < 4096; b += nth) {
        const int blk = b >> lgq, j = b & (q - 1), base = blk * n + j;
        float sn, cs; sincos_turns((float)(j << (2 * s)) * (1.0f / 16384.0f), sn, cs);
        cf w; w.x = cs; w.y = sn; const cf w2 = cmul(w, w), w3 = cmul(w2, w);
        cf b0 = x[PX(base)], b1 = cmul(x[PX(base + q)], w), b2 = cmul(x[PX(base + 2 * q)], w2), b3 = cmul(x[PX(base + 3 * q)], w3);
        bfly_inv(b0, b1, b2, b3);
        x[PX(base)] = b0; x[PX(base + q)] = b1; x[PX(base + 2 * q)] = b2; x[PX(base + 3 * q)] = b3;
    }
}
HD cf tw16(int k) {
    const float c1 = 0.92387953251128674f, s1 = 0.38268343236508977f, c2 = 0.70710678118654752f;
    cf r;
    switch (k) { case 0: r.x = 1.f; r.y = 0.f; break; case 1: r.x = c1; r.y = -s1; break; case 2: r.x = c2; r.y = -c2; break; case 3: r.x = s1; r.y = -c1; break;
                 case 4: r.x = 0.f; r.y = -1.f; break; case 6: r.x = -c2; r.y = -c2; break; case 9: r.x = -c1; r.y = s1; break; default: r.x = 0.f; r.y = 0.f; break; }
    return r;
}
template <class P> HD void fft_fwd_pair(P x, int s, int tid, int nth) {
    const int lgq4 = 10 - 2 * s, q4 = 1 << lgq4;
    for (int gidx = tid; gidx < 1024; gidx += nth) {
        const int blk = gidx >> lgq4, jp = gidx & (q4 - 1), base = (blk << (lgq4 + 4)) + jp;
        cf v[16];
#pragma unroll
        for (int i = 0; i < 16; ++i) v[i] = x[PX(base + (i << lgq4))];
        float sn0, cs0; sincos_turns((float)(jp << (2 * s)) * (1.0f / 16384.0f), sn0, cs0);
        cf wb; wb.x = cs0; wb.y = -sn0; const cf wb2 = cmul(wb, wb);
#pragma unroll
        for (int il = 0; il < 4; ++il) { bfly_fwd(v[il], v[il + 4], v[il + 8], v[il + 12]);
            const cf w = il == 0 ? wb : cmul(wb, tw16(il)); const cf w2 = il == 0 ? wb2 : cmul(w, w), w3 = cmul(w2, w);
            v[il + 4] = cmul(v[il + 4], w); v[il + 8] = cmul(v[il + 8], w2); v[il + 12] = cmul(v[il + 12], w3); }
        { const cf w = cmul(wb2, wb2); const cf w2 = cmul(w, w), w3 = cmul(w2, w);
#pragma unroll
          for (int r = 0; r < 4; ++r) { bfly_fwd(v[4 * r], v[4 * r + 1], v[4 * r + 2], v[4 * r + 3]);
              v[4 * r + 1] = cmul(v[4 * r + 1], w); v[4 * r + 2] = cmul(v[4 * r + 2], w2); v[4 * r + 3] = cmul(v[4 * r + 3], w3); } }
#pragma unroll
        for (int i = 0; i < 16; ++i) x[PX(base + (i << lgq4))] = v[i];
    }
}
template <class P> HD void fft_inv_pair(P x, int s, int tid, int nth) {
    const int lgq4 = 10 - 2 * s, q4 = 1 << lgq4;
    for (int gidx = tid; gidx < 1024; gidx += nth) {
        const int blk = gidx >> lgq4, jp = gidx & (q4 - 1), base = (blk << (lgq4 + 4)) + jp;
        cf v[16];
#pragma unroll
        for (int i = 0; i < 16; ++i) v[i] = x[PX(base + (i << lgq4))];
        float sn0, cs0; sincos_turns((float)(jp << (2 * s)) * (1.0f / 16384.0f), sn0, cs0);
        cf wb; wb.x = cs0; wb.y = sn0; const cf wb2 = cmul(wb, wb);
        { const cf w = cmul(wb2, wb2); const cf w2 = cmul(w, w), w3 = cmul(w2, w);
#pragma unroll
          for (int r = 0; r < 4; ++r) { v[4 * r + 1] = cmul(v[4 * r + 1], w); v[4 * r + 2] = cmul(v[4 * r + 2], w2); v[4 * r + 3] = cmul(v[4 * r + 3], w3);
              bfly_inv(v[4 * r], v[4 * r + 1], v[4 * r + 2], v[4 * r + 3]); } }
#pragma unroll
        for (int il = 0; il < 4; ++il) {
            const cf w = il == 0 ? wb : cmul(wb, cconj(tw16(il))); const cf w2 = il == 0 ? wb2 : cmul(w, w), w3 = cmul(w2, w);
            v[il + 4] = cmul(v[il + 4], w); v[il + 8] = cmul(v[il + 8], w2); v[il + 12] = cmul(v[il + 12], w3);
            bfly_inv(v[il], v[il + 4], v[il + 8], v[il + 12]); }
#pragma unroll
        for (int i = 0; i < 16; ++i) x[PX(base + (i << lgq4))] = v[i];
    }
}
template <class P> HD void fft16_fwd(P x, int tid, int nth) {
    for (int blk = tid; blk < 1024; blk += nth) {
        cf v[16];
#pragma unroll
        for (int i = 0; i < 16; ++i) v[i] = x[PX(blk * 16 + i)];
#pragma unroll
        for (int j = 0; j < 4; ++j) { bfly_fwd(v[j], v[j + 4], v[j + 8], v[j + 12]);
            if (j > 0) { v[j + 4] = cmul(v[j + 4], tw16(j)); v[j + 8] = cmul(v[j + 8], tw16(2 * j)); v[j + 12] = cmul(v[j + 12], tw16(3 * j)); } }
#pragma unroll
        for (int b = 0; b < 4; ++b) bfly_fwd(v[4 * b], v[4 * b + 1], v[4 * b + 2], v[4 * b + 3]);
#pragma unroll
        for (int i = 0; i < 16; ++i) x[PX(blk * 16 + i)] = v[i];
    }
}
template <class P> HD void fft16_inv(P x, int tid, int nth) {
    for (int blk = tid; blk < 1024; blk += nth) {
        cf v[16];
#pragma unroll
        for (int i = 0; i < 16; ++i) v[i] = x[PX(blk * 16 + i)];
#pragma unroll
        for (int b = 0; b < 4; ++b) bfly_inv(v[4 * b], v[4 * b + 1], v[4 * b + 2], v[4 * b + 3]);
#pragma unroll
        for (int j = 0; j < 4; ++j) {
            if (j > 0) { v[j + 4] = cmul(v[j + 4], cconj(tw16(j))); v[j + 8] = cmul(v[j + 8], cconj(tw16(2 * j))); v[j + 12] = cmul(v[j + 12], cconj(tw16(3 * j))); }
            bfly_inv(v[j], v[j + 4], v[j + 8], v[j + 12]); }
#pragma unroll
        for (int i = 0; i < 16; ++i) x[PX(blk * 16 + i)] = v[i];
    }
}
template <class P> HD void filt_unpack(P x, cf* Kout, int tid, int nth) {
    for (int f = tid; f <= FM / 2; f += nth) {
        if (f == 0) { const cf a = x[PX(0)]; cf k; k.x = a.x + a.y; k.y = a.x - a.y; Kout[0] = k; continue; }
        const int g = FM - f; const cf A = x[PX(rev4_14(f))], B = x[PX(rev4_14(g))];
        cf E, O; E.x = 0.5f * (A.x + B.x); E.y = 0.5f * (A.y - B.y);
        O.x = 0.5f * (A.y + B.y); O.y = -0.5f * (A.x - B.x);
        float sn, cs; sincos_turns((float)f / (float)(2 * FM), sn, cs); cf w; w.x = cs; w.y = -sn;
        const cf T = cmul(w, O);
        Kout[f] = cadd(E, T); Kout[g] = cconj(csub(E, T));
    }
}
template <class P> HD void conv_pointwise(P x, const cf* K, int tid, int nth) {
    const float sc = 1.0f / (float)FM;
    for (int f0 = tid; f0 <= FM / 2; f0 += 8 * nth) {
        cf kfv[8], kgv[8];
#pragma unroll
        for (int i = 0; i < 8; ++i) { const int f = f0 + i * nth; if (f <= FM / 2) { kfv[i] = K[f]; kgv[i] = K[(FM - f) & (FM - 1)]; } }
#pragma unroll
        for (int i = 0; i < 8; ++i) { const int f = f0 + i * nth; if (f > FM / 2) continue;
            if (f == 0) { const cf a = x[PX(0)]; const cf k = kfv[i]; const float y0 = (a.x + a.y) * k.x, ym = (a.x - a.y) * k.y; cf r; r.x = 0.5f * (y0 + ym) * sc; r.y = 0.5f * (y0 - ym) * sc; x[PX(0)] = r; continue; }
            const int g = FM - f, pf = PX(rev4_14(f)), pg = PX(rev4_14(g)); const cf A = x[pf], B = x[pg];
            cf E, O; E.x = 0.5f * (A.x + B.x); E.y = 0.5f * (A.y - B.y); O.x = 0.5f * (A.y + B.y); O.y = -0.5f * (A.x - B.x);
            float sn, cs; sincos_turns((float)f * (1.0f / (float)(2 * FM)), sn, cs); cf w; w.x = cs; w.y = -sn;
            const cf T = cmul(w, O);
            const cf Xf = cadd(E, T), Xg = cconj(csub(E, T));
            const cf Yf = cmul(Xf, kfv[i]), Yg = cmul(Xg, kgv[i]);
            cf Pp, Qq; Pp.x = 0.5f * (Yf.x + Yg.x); Pp.y = 0.5f * (Yf.y - Yg.y);
            cf Dd; Dd.x = 0.5f * (Yf.x - Yg.x); Dd.y = 0.5f * (Yf.y + Yg.y);
            Qq = cmul(Dd, cconj(w));
            cf cfv, cgv; cfv.x = (Pp.x - Qq.y) * sc; cfv.y = (Pp.y + Qq.x) * sc;
            cgv.x = (Pp.x + Qq.y) * sc; cgv.y = (-Pp.y + Qq.x) * sc;
            x[pf] = cfv; x[pg] = cgv; }
    }
}

#if !defined(HOST_TEST)
DI void phase_adaln(PP4 P, LAS unsigned char* lds) {
    LAS float* sv = (LAS float*)lds;
    LAS float* red = sv + 3 * 1024;
    const int tid = otid(), wave = tid >> 6, lane = tid & 63;
    for (int i = tid; i < 3 * 1024; i += NT) { const int j = i >> 10, k = i & 1023; const float cvv = j < 2 ? P->in[I_C][j * 1024 + k] : P->in[I_CCTX][k]; sv[i] = silu_f(cvv); }
    __syncthreads();
    float* MOD = (float*)(P->ws + O_MOD);
    for (int item = obid(); item < 192; item += ogrid()) {
        const int l = item / 96, cgp = item % 96, n = cgp * 64 + lane;
        const float* W = P->in[I_ADAW] + (size_t)l * 1024 * 6144 + n;
        float a0 = 0.f, a1 = 0.f, a2 = 0.f;
#pragma unroll 16
        for (int kk = 0; kk < 128; ++kk) { const int k = wave * 128 + kk; const float w = W[(size_t)k * 6144]; a0 += sv[k] * w; a1 += sv[1024 + k] * w; a2 += sv[2048 + k] * w; }
        red[(wave * 3 + 0) * 64 + lane] = a0; red[(wave * 3 + 1) * 64 + lane] = a1; red[(wave * 3 + 2) * 64 + lane] = a2;
        __syncthreads();
        if (tid < 192) { const int j = tid >> 6, ln = tid & 63; float s = 0.f;
#pragma unroll
            for (int w = 0; w < 8; ++w) s += red[(w * 3 + j) * 64 + ln];
            MOD[((size_t)l * 3 + j) * 6144 + cgp * 64 + ln] = s + P->in[I_ADAB][(size_t)l * 6144 + cgp * 64 + ln]; }
        __syncthreads();
    }
}

DI int win_src_col(int n) {
    if (n < 3072) return n;
    if (n < 4608) return n + 32;
    if (n < 7680) return n + 32;
    if (n < 7712) return n - 7680 + 3072;
    return -1;
}
DI void wt_tile(const float* W, int K, int N, bf16_t* WT, int k0, int n0, int mode, LAS float* tile) {
    const int tid = otid();
    const int nn = tid & 127; const int nd = n0 + nn; const int sc = mode ? win_src_col(nd) : nd;
    float v[16];
#pragma unroll
    for (int i = 0; i < 16; ++i) { const int kk = (tid >> 7) + 4 * i; v[i] = sc >= 0 ? W[(size_t)(k0 + kk) * N + sc] : 0.f; }
#pragma unroll
    for (int i = 0; i < 16; ++i) { const int kk = (tid >> 7) + 4 * i; tile[kk * 129 + nn] = v[i]; }
    __syncthreads();
    { const int n = tid >> 2, k16 = (tid & 3) * 16; const LAS float* s = tile + k16 * 129 + n;
      u32x4 o0, o1;
      o0.x = pk2(s[0], s[129]); o0.y = pk2(s[2 * 129], s[3 * 129]); o0.z = pk2(s[4 * 129], s[5 * 129]); o0.w = pk2(s[6 * 129], s[7 * 129]);
      o1.x = pk2(s[8 * 129], s[9 * 129]); o1.y = pk2(s[10 * 129], s[11 * 129]); o1.z = pk2(s[12 * 129], s[13 * 129]); o1.w = pk2(s[14 * 129], s[15 * 129]);
      bf16_t* dst = WT + (size_t)(n0 + n) * K + k0 + k16; *(u32x4*)dst = o0; *(u32x4*)(dst + 8) = o1; }
    __syncthreads();
}
constexpr int WT_T_IN = 16 * (NIN / 128), WT_T_BR = WT_T_IN + 3 * 8 * 8, WT_T_OUT = WT_T_BR + 16 * 8, WT_T_UP = WT_T_OUT + 16 * 44, WT_T_DN = WT_T_UP + 44 * 8;
DI void phase_wconv(PP4 P, LAS unsigned char* lds, int l, int lo, int hi, int rank, int nranks) {
    LAS float* tile = (LAS float*)lds;
    bf16_t* WT = (bf16_t*)(P->ws + O_WT);
    constexpr int T_IN = 16 * (NIN / 128), T_BR = 3 * 8 * 8, T_OUT = 16 * 8, T_UP = 16 * 44, T_DN = 44 * 8, T_ALL = T_IN + T_BR + T_OUT + T_UP + T_DN;
    for (int it = lo + rank; it < hi && it < T_ALL; it += nranks) {
        int r = it;
        if (r < T_IN) { const int nb = r / 16, kb = r % 16; wt_tile(P->in[I_WIN] + (size_t)l * 1024 * 7712, 1024, 7712, WT + WT_IN, kb * 64, nb * 128, 1, tile); continue; } r -= T_IN;
        if (r < T_BR) { const int br = r / 64, r2 = r % 64, nb = r2 / 8, kb = r2 % 8; wt_tile(P->in[I_WBR] + ((size_t)l * 3 + br) * 512 * 1024, 512, 1024, WT + WT_BR + (size_t)br * 1024 * 512, kb * 64, nb * 128, 0, tile); continue; } r -= T_BR;
        if (r < T_OUT) { const int nb = r / 16, kb = r % 16; wt_tile(P->in[I_WOUT] + (size_t)l * 1024 * 1024, 1024, 1024, WT + WT_OUT, kb * 64, nb * 128, 0, tile); continue; } r -= T_OUT;
        if (r < T_UP) { const int nb = r / 16, kb = r % 16; wt_tile(P->in[I_WUP] + (size_t)l * 1024 * 5632, 1024, 5632, WT + WT_UP, kb * 64, nb * 128, 0, tile); continue; } r -= T_UP;
        { const int nb = r / 44, kb = r % 44; wt_tile(P->in[I_WDN] + (size_t)l * 2816 * 1024, 2816, 1024, WT + WT_DN, kb * 64, nb * 128, 0, tile); }
    }
}

DI float sin_fast(float x) { return __builtin_amdgcn_sinf(x * 0.15915494309189535f); }
DI void phase_filt1(PP4 P, LAS unsigned char* lds, int l, int rank, int nranks) {
    const int tid = otid(), wave = tid >> 6, lane = tid & 63;
    LAS float* feat = (LAS float*)lds + wave * 128;
    LAS float* hid = feat + 64;
    const float* w1 = P->in[I_HW1] + (size_t)l * 33 * 64; const float* w2 = P->in[I_HW2] + (size_t)l * 2 * 64 * 64;
    float w1r[33], w2a[64], w2b[64];
#pragma unroll
    for (int f = 0; f < 33; ++f) w1r[f] = w1[f * 64 + lane];
#pragma unroll
    for (int k = 0; k < 64; ++k) { w2a[k] = w2[k * 64 + lane]; w2b[k] = w2[4096 + k * 64 + lane]; }
    const float b1v = P->in[I_HB1][l * 64 + lane], b2a = P->in[I_HB2][l * 128 + lane], b2b = P->in[I_HB2][l * 128 + 64 + lane];
    const float fq = P->in[I_HFREQ][l * 64 + lane];
    float* HDN = (float*)(P->ws + O_HDN);
    for (int base = rank * 8; base < 16640; base += nranks * 8) {
        const int pos = base + wave; const int L = pos < 16384 ? 16384 : 256; const int i = pos < 16384 ? pos : pos - 16384;
        if (lane == 0) feat[0] = (float)i / (float)(L - 1);
        if (lane < 16) { const float band = 1e-4f + (float)lane * ((15.0f - 1e-4f) / 15.0f); const float turns = (float)i * band * (1.0f / (float)L);
            feat[1 + lane] = __builtin_amdgcn_cosf(turns); feat[17 + lane] = -__builtin_amdgcn_sinf(turns); }
        __syncthreads();
        float a = b1v;
#pragma unroll
        for (int f = 0; f < 33; ++f) a += feat[f] * w1r[f];
        float h = sin_fast(fq * a);
        hid[lane] = h;
        __syncthreads();
        float s0 = b2a;
#pragma unroll
        for (int k4 = 0; k4 < 16; ++k4) { const f32x4 hv = *(const LAS f32x4*)(hid + 4 * k4); s0 += hv[0] * w2a[4 * k4] + hv[1] * w2a[4 * k4 + 1] + hv[2] * w2a[4 * k4 + 2] + hv[3] * w2a[4 * k4 + 3]; }
        h = sin_fast(fq * s0);
        __syncthreads();
        hid[lane] = h;
        __syncthreads();
        float s1 = b2b;
#pragma unroll
        for (int k4 = 0; k4 < 16; ++k4) { const f32x4 hv = *(const LAS f32x4*)(hid + 4 * k4); s1 += hv[0] * w2b[4 * k4] + hv[1] * w2b[4 * k4 + 1] + hv[2] * w2b[4 * k4 + 2] + hv[3] * w2b[4 * k4 + 3]; }
        h = sin_fast(fq * s1);
        HDN[(size_t)pos * 64 + lane] = h;
        __syncthreads();
    }
}
DI float hy_window(int i, int L, int c) {
    const float mn = -3.0701134573253946f, mx = -15.350567286626973f;
    const float delta = fabsf(mn + (float)c * ((mx - mn) / 511.0f)); const float t = (float)i / (float)(L - 1);
    return expf(-t * delta) + 0.05f;
}
DI void phase_filt2(PP4 P, LAS unsigned char* lds, int l) {
    LAS float* hd = (LAS float*)lds;
    LAS float* wf = hd + 64 * 65;
    LAS float* wb = wf + 4096;
    LAS float* ot = wb + 4096;
    const int tid = otid(), wave = tid >> 6, lane = tid & 63;
    const float* HDN = (const float*)(P->ws + O_HDN); const float* w3 = P->in[I_HW3] + (size_t)l * 64 * 1024; const float* hb = P->in[I_HBIAS] + l * 512;
    float* KT = (float*)(P->ws + O_K); float* HFC = (float*)(P->ws + O_HFC);
    for (int item = obid(); item < 2080; item += ogrid()) {
        const int lt = item >> 3, ct = item & 7; const bool isctx = lt >= 256; const int lag0 = isctx ? (lt - 256) * 64 : lt * 64; const int c0 = ct * 64;
        const int prow = isctx ? 16384 + lag0 : lag0;
#pragma unroll
        for (int i = tid; i < 4096; i += NT) { const int r = i >> 6, u = i & 63; hd[r * 65 + u] = HDN[(size_t)(prow + r) * 64 + u]; wf[i] = w3[(size_t)r * 1024 + c0 + u]; wb[i] = w3[(size_t)r * 1024 + 512 + c0 + u]; }
        __syncthreads();
        { const int r = lane & 15, q = lane >> 4; const LAS float* bsrc = (wave < 4 ? wf : wb) + 16 * (wave & 3) + r;
          f32x4 acc[4];
#pragma unroll
          for (int mt = 0; mt < 4; ++mt) acc[mt] = (f32x4){0.f, 0.f, 0.f, 0.f};
#pragma unroll 4
          for (int kk = 0; kk < 16; ++kk) { const float bv = bsrc[(4 * kk + q) * 64];
#pragma unroll
              for (int mt = 0; mt < 4; ++mt) acc[mt] = __builtin_amdgcn_mfma_f32_16x16x4f32(hd[(16 * mt + r) * 65 + 4 * kk + q], bv, acc[mt], 0, 0, 0); }
#pragma unroll
          for (int mt = 0; mt < 4; ++mt)
#pragma unroll
              for (int e = 0; e < 4; ++e) ot[(16 * wave + r) * 65 + 16 * mt + 4 * q + e] = acc[mt][e]; }
        __syncthreads();
        float af[8], ab[8];
#pragma unroll
        for (int j = 0; j < 8; ++j) { af[j] = ot[(wave * 8 + j) * 65 + lane]; ab[j] = ot[(64 + wave * 8 + j) * 65 + lane]; }
        const int lag = lag0 + lane;
#pragma unroll
        for (int j = 0; j < 8; ++j) { const int c = c0 + wave * 8 + j;
            if (!isctx) { const float wn = hy_window(lag, 16384, c); float* slot = KT + (size_t)c * 32768;
                slot[lag] = af[j] * wn + (lag == 0 ? hb[c] : 0.f);
                if (lag == 0) slot[16384] = 0.f; else slot[32768 - lag] = ab[j] * wn;
            } else { const float wn = hy_window(lag, 256, c);
                HFC[(size_t)lag * 512 + c] = af[j] * wn + (lag == 0 ? hb[c] : 0.f); HFC[(size_t)(256 + lag) * 512 + c] = ab[j] * wn; } }
        __syncthreads();
    }
}
DI void fft_fwd_all(LAS cf* x) { const int tid = otid(); fft_fwd_pair(x, 0, tid, NT); __syncthreads(); fft_fwd_pair(x, 2, tid, NT); __syncthreads(); fft_fwd_stage(x, 4, tid, NT); __syncthreads(); fft16_fwd(x, tid, NT); __syncthreads(); }
DI void fft_inv_all(LAS cf* x) { const int tid = otid(); fft16_inv(x, tid, NT); __syncthreads(); fft_inv_stage(x, 4, tid, NT); __syncthreads(); fft_inv_pair(x, 2, tid, NT); __syncthreads(); fft_inv_pair(x, 0, tid, NT); __syncthreads(); }
DI void phase_filt3(PP4 P, LAS unsigned char* lds) {
    LAS cf* x = (LAS cf*)lds; const int tid = otid();
    for (int c = obid(); c < 512; c += ogrid()) {
        cf* slot = (cf*)(P->ws + O_K) + (size_t)c * FM;
#pragma unroll
        for (int hb = 0; hb < 2; ++hb) { cf tv[16];
#pragma unroll
            for (int i = 0; i < 16; ++i) tv[i] = slot[tid + NT * (16 * hb + i)];
#pragma unroll
            for (int i = 0; i < 16; ++i) x[PX(tid + NT * (16 * hb + i))] = tv[i]; }
        __syncthreads();
        fft_fwd_all(x);
        filt_unpack(x, slot, tid, NT);
        __syncthreads();
    }
}

DI const float* mod_rowptr(PP4 P, int R, bool from_input) {
    const int b = R / RB, rr = R - b * RB;
    return rr < CTX ? (from_input ? P->in[I_CTX] : (const float*)(P->ws + O_XCTX)) + ((size_t)b * CTX + rr) * D : (from_input ? P->in[I_X] : P->out) + ((size_t)b * SEQ + rr - CTX) * D;
}
DI void phase_modulate(PP4 P, int l, int which, int r_lo, int r_hi, bf16_t* hout  , bool from_input) {
    const int tid = otid(), wave = tid >> 6, lane = tid & 63;
    const float* gam = (which == 0 ? P->in[I_N1G] : P->in[I_N2G]) + l * 1024;
    const float* MOD = (const float*)(P->ws + O_MOD) + (size_t)l * 3 * 6144;
    const int stride = ogrid() * 8;
    int R = r_lo + obid() * 8 + wave;
    f32x4 v[4], vn[4];
    if (R < r_hi) { const float* xr = mod_rowptr(P, R, from_input);
#pragma unroll
        for (int j = 0; j < 4; ++j) v[j] = *(const f32x4*)(xr + 256 * j + 4 * lane); }
    for (; R < r_hi; R += stride) {
        if (R + stride < r_hi) { const float* xn = mod_rowptr(P, R + stride, from_input);
#pragma unroll
            for (int j = 0; j < 4; ++j) vn[j] = *(const f32x4*)(xn + 256 * j + 4 * lane); }
        const int b = R / RB, rr = R - b * RB; const bool isctx = rr < CTX;
        const float* mv = MOD + (isctx ? 2 : b) * 6144 + which * 3072;
        float s = 0.f;
#pragma unroll
        for (int j = 0; j < 4; ++j) s += v[j][0] * v[j][0] + v[j][1] * v[j][1] + v[j][2] * v[j][2] + v[j][3] * v[j][3];
        const float rs = rsqrtf(wave_sum(s) * (1.0f / 1024.0f) + 1e-6f);
        bf16_t* orow = hout + (size_t)(R - r_lo) * D;
#pragma unroll
        for (int j = 0; j < 4; ++j) { const int c = 256 * j + 4 * lane; const f32x4 g = *(const f32x4*)(gam + c), sh = *(const f32x4*)(mv + c), sc = *(const f32x4*)(mv + 1024 + c);
            const f32x4 y = v[j] * rs * g * (1.0f + sc) + sh;
            u32x2 w; w.x = pk2(y[0], y[1]); w.y = pk2(y[2], y[3]); *(u32x2*)(orow + c) = w; }
#pragma unroll
        for (int j = 0; j < 4; ++j) v[j] = vn[j];
    }
}

constexpr int S_CUM = 0, S_QIN = 40960, S_KK = 59392, S_SB = 77824, S_VT = 96256, S_HT = 114688;
constexpr int TS = 72;
constexpr int CS = 65;
DI int chain_pos(int d, int Bk) { return d == 0 ? Bk : (Bk < 4 ? 3 - Bk : 263 - Bk); }
template <int PH>
DI void scan_item(PP4 P, LAS unsigned char* lds, int l, int item) {
    const int tid = otid(), wave = __builtin_amdgcn_readfirstlane(tid >> 6), lane = tid & 63;
    const int mx = item / (NBLK * 4), rem = item % (NBLK * 4), Bk = rem >> 2, h = rem & 3;
    const int row0 = Bk * 64;
    const bf16_t* PP = (const bf16_t*)(P->ws + (mx == 0 ? O_PRET : O_PGLA));
    bf16_t* U = (bf16_t*)(P->ws + O_U); float* AB = (float*)(P->ws + O_ABUF);
    LAS float* cum = (LAS float*)(lds + S_CUM);
    float* CUMG = (float*)(P->ws + O_H);
    const float qs = mx == 0 ? 1.0f : 0.125f, ks = mx == 0 ? 0.125f : 1.0f;
    const int tok = tid >> 3, c8 = (tid & 7) * 8, c16 = (tid & 7) * 16; const bf16_t* prow = PP + (size_t)(row0 + tok) * 1536;
    const u32x4 kv = *(const u32x4*)(prow + 256 + 64 * h + c8);
    u32x4 qv = (u32x4){0u, 0u, 0u, 0u}; if (PH == 3) qv = *(const u32x4*)(prow + 64 * h + c8);
    const u32x4 v0 = *(const u32x4*)(prow + 512 + 128 * h + c16), v1 = *(const u32x4*)(prow + 512 + 128 * h + c16 + 8);
    u32x4 g0 = (u32x4){0u, 0u, 0u, 0u}, g1 = g0, hreg[4];
    if (PH == 3) { g0 = *(const u32x4*)(prow + 1024 + 128 * h + c16); g1 = *(const u32x4*)(prow + 1024 + 128 * h + c16 + 8);
#pragma unroll
        for (int i = 0; i < 4; ++i) { const int idx = tid + NT * i, d = idx >> 10, r2 = idx & 1023, dv = r2 >> 3, cc = (r2 & 7) * 8;
            const size_t ch = (size_t)((mx * 4 + h) * 2 + d) * NBLK + chain_pos(d, Bk);
            hreg[i] = *(const u32x4*)(U + ch * 8192 + dv * 64 + cc); } }
    if (PH == 3) {
    } else if (mx == 0) {
#pragma unroll
        for (int d = 0; d < 2; ++d) { const float la = log1pf(-exp2f(-(d == 0 ? 5.0f : 5.5f) - (float)h)); const float cv = d == 0 ? (float)(lane + 1) * la : (float)(64 - lane) * la;
#pragma unroll
            for (int j = 0; j < 8; ++j) cum[(d * 64 + lane) * CS + 8 * wave + j] = cv; }
    } else {
        LAS float* lrs = (LAS float*)(lds + S_SB);
        LAS float* wl = lrs + 64 * 36;
        { const f32x4 lt = *(const f32x4*)((const float*)(P->ws + O_LR) + (size_t)row0 * 32 + tid * 4); *(LAS f32x4*)(lrs + (tid >> 3) * 36 + (tid & 7) * 4) = lt;
          const int i4 = tid * 4, dd = i4 >> 10, rr = (i4 >> 6) & 15, cc = i4 & 63;
          *(LAS f32x4*)(wl + i4) = *(const f32x4*)(P->in[I_WA2] + ((size_t)(l * 2 + dd) * 16 + rr) * 256 + 64 * h + cc); }
        __syncthreads();
        { const int d = wave >> 2, ct = wave & 3, r = lane & 15, q = lane >> 4;
          const float bias = P->in[I_BA][(l * 2 + d) * 256 + 64 * h + 16 * ct + r];
          f32x4 acc[4];
#pragma unroll
          for (int mt = 0; mt < 4; ++mt) acc[mt] = (f32x4){bias, bias, bias, bias};
#pragma unroll
          for (int k4 = 0; k4 < 4; ++k4) { const float bv = wl[(d * 16 + 4 * k4 + q) * 64 + 16 * ct + r];
#pragma unroll
              for (int mt = 0; mt < 4; ++mt) acc[mt] = __builtin_amdgcn_mfma_f32_16x16x4f32(lrs[(16 * mt + r) * 36 + 16 * d + 4 * k4 + q], bv, acc[mt], 0, 0, 0); }
          float la[4][4], inc[4][4], pq[4], tm[4];
#pragma unroll
          for (int mt = 0; mt < 4; ++mt) { float run = 0.f;
#pragma unroll
              for (int e = 0; e < 4; ++e) { const float x = acc[mt][e]; la[mt][e] = (fminf(x, 0.f) - __logf(1.0f + __expf(-fabsf(x)))) * (1.0f / 16.0f); run += la[mt][e]; inc[mt][e] = run; }
              float t = run;
              { const float u1 = __shfl_up(t, 16); if (q >= 1) t += u1; const float u2 = __shfl_up(t, 32); if (q >= 2) t += u2; }
              pq[mt] = t - run;
              tm[mt] = __shfl(t, 48 + r); }
          float off = 0.f; const float total = (tm[0] + tm[1]) + (tm[2] + tm[3]);
#pragma unroll
          for (int mt = 0; mt < 4; ++mt) {
#pragma unroll
              for (int e = 0; e < 4; ++e) { const float pf = off + pq[mt] + inc[mt][e];
                  cum[(d * 64 + 16 * mt + 4 * q + e) * CS + 16 * ct + r] = d == 0 ? pf : total - pf + la[mt][e]; }
              off += tm[mt]; } }
    }
    if (PH == 1) __syncthreads();
    LAS bf16_t* qin = (LAS bf16_t*)(lds + S_QIN); LAS bf16_t* kk = (LAS bf16_t*)(lds + S_KK); LAS bf16_t* sb = (LAS bf16_t*)(lds + S_SB);
    LAS bf16_t* vT = (LAS bf16_t*)(lds + S_VT); LAS bf16_t* hT = (LAS bf16_t*)(lds + S_HT);
    { float kf[8], qf[8];
#pragma unroll
      for (int j = 0; j < 4; ++j) { kf[2 * j] = __uint_as_float(kv[j] << 16) * ks; kf[2 * j + 1] = __uint_as_float(kv[j] & 0xffff0000u) * ks; qf[2 * j] = __uint_as_float(qv[j] << 16) * qs; qf[2 * j + 1] = __uint_as_float(qv[j] & 0xffff0000u) * qs; }
#pragma unroll
      for (int d = 0; d < 2; ++d) {
          if (PH == 3) { float qo[8], ko[8];
              float cu8[8];
              if (mx == 0) { const float la = log1pf(-exp2f(-(d == 0 ? 5.0f : 5.5f) - (float)h)); const float cv = d == 0 ? (float)(tok + 1) * la : (float)(64 - tok) * la;
#pragma unroll
                  for (int j = 0; j < 8; ++j) cu8[j] = cv;
              } else { const float* cg = CUMG + ((size_t)d * RB + row0 + tok) * 256 + 64 * h + c8; const f32x4 ca = *(const f32x4*)cg, cb2 = *(const f32x4*)(cg + 4);
#pragma unroll
                  for (int j = 0; j < 4; ++j) { cu8[j] = ca[j]; cu8[4 + j] = cb2[j]; } }
#pragma unroll
              for (int j = 0; j < 8; ++j) { const float cu = cu8[j]; qo[j] = qf[j] * __expf(cu); ko[j] = kf[j] * __expf(-cu); }
              u32x4 w; w.x = pk2(qo[0], qo[1]); w.y = pk2(qo[2], qo[3]); w.z = pk2(qo[4], qo[5]); w.w = pk2(qo[6], qo[7]); *(LAS u32x4*)(qin + (d * 64 + tok) * TS + c8) = w;
              w.x = pk2(ko[0], ko[1]); w.y = pk2(ko[2], ko[3]); w.z = pk2(ko[4], ko[5]); w.w = pk2(ko[6], ko[7]); *(LAS u32x4*)(kk + (d * 64 + tok) * TS + c8) = w;
          } else {
              float cu8[8];
#pragma unroll
              for (int j = 0; j < 8; ++j) { const int ch = c8 + j; const float tot = d == 0 ? cum[63 * CS + ch] : cum[64 * CS + ch]; const float cu = cum[(d * 64 + tok) * CS + ch]; cu8[j] = cu;
                  qin[(d * 64 + ch) * TS + (tok ^ (((ch >> 3) & 7) << 3))] = f2bf(kf[j] * __expf(tot - cu)); }
              if (mx == 1) { float* cg = CUMG + ((size_t)d * RB + row0 + tok) * 256 + 64 * h + c8;
                  *(f32x4*)cg = (f32x4){cu8[0], cu8[1], cu8[2], cu8[3]}; *(f32x4*)(cg + 4) = (f32x4){cu8[4], cu8[5], cu8[6], cu8[7]}; }
          } }
#pragma unroll
      for (int j = 0; j < 4; ++j) { const int tsw = tok ^ ((tid & 7) << 3);
          vT[(c16 + 2 * j) * TS + tsw] = (bf16_t)(v0[j] & 0xffffu); vT[(c16 + 2 * j + 1) * TS + tsw] = (bf16_t)(v0[j] >> 16);
          vT[(c16 + 8 + 2 * j) * TS + tsw] = (bf16_t)(v1[j] & 0xffffu); vT[(c16 + 8 + 2 * j + 1) * TS + tsw] = (bf16_t)(v1[j] >> 16); }
      if (PH == 3) {
#pragma unroll
          for (int i = 0; i < 4; ++i) { const int idx = tid + NT * i, d = idx >> 10, r2 = idx & 1023, dv = r2 >> 3, cc = (r2 & 7) * 8; *(LAS u32x4*)(hT + (d * 128 + dv) * TS + cc) = hreg[i]; } }
    }
    __syncthreads();
    const int d = wave >> 2, s = wave & 3, fr = lane & 15, fq = lane >> 4;
    if (PH == 1) {
        f32x4 u[4][2];
#pragma unroll
        for (int mi = 0; mi < 4; ++mi)
#pragma unroll
            for (int ni = 0; ni < 2; ++ni) u[mi][ni] = (f32x4){0.f, 0.f, 0.f, 0.f};
#pragma unroll
        for (int kst = 0; kst < 2; ++kst) { bf16x8 bv[2];
#pragma unroll
            for (int ni = 0; ni < 2; ++ni) bv[ni] = *(const LAS bf16x8*)(vT + (16 * (2 * s + ni) + fr) * TS + ((kst * 32 + fq * 8) ^ (((2 * s + ni) & 7) << 3)));
#pragma unroll
            for (int mi = 0; mi < 4; ++mi) { const bf16x8 a = *(const LAS bf16x8*)(qin + (d * 64 + 16 * mi + fr) * TS + ((kst * 32 + fq * 8) ^ (((2 * mi + (fr >> 3)) & 7) << 3)));
#pragma unroll
                for (int ni = 0; ni < 2; ++ni) u[mi][ni] = __builtin_amdgcn_mfma_f32_16x16x32_bf16(a, bv[ni], u[mi][ni], 0, 0, 0); } }
        const size_t chn = (size_t)((mx * 4 + h) * 2 + d) * NBLK + chain_pos(d, Bk);
        if (s == 0) AB[chn * 64 + lane] = __expf(d == 0 ? cum[63 * CS + lane] : cum[64 * CS + lane]);
#pragma unroll
        for (int mi = 0; mi < 4; ++mi)
#pragma unroll
            for (int ni = 0; ni < 2; ++ni) { u32x2 w; w.x = pk2(u[mi][ni][0], u[mi][ni][1]); w.y = pk2(u[mi][ni][2], u[mi][ni][3]);
                *(LAS u32x2*)(hT + (d * 128 + 16 * (2 * s + ni) + fr) * TS + 16 * mi + 4 * fq) = w; }
        __syncthreads();
#pragma unroll
        for (int i = 0; i < 4; ++i) { const int idx = tid + NT * i, dd = idx >> 10, r2 = idx & 1023, dv = r2 >> 3, cc = (r2 & 7) * 8;
            const size_t ch2 = (size_t)((mx * 4 + h) * 2 + dd) * NBLK + chain_pos(dd, Bk);
            *(u32x4*)(U + ch2 * 8192 + dv * 64 + cc) = *(const LAS u32x4*)(hT + (dd * 128 + dv) * TS + cc); }
        __syncthreads();
    } else {
        f32x4 sc[4];
#pragma unroll
        for (int nt = 0; nt < 4; ++nt) sc[nt] = (f32x4){0.f, 0.f, 0.f, 0.f};
#pragma unroll
        for (int kst = 0; kst < 2; ++kst) { const bf16x8 bq = *(const LAS bf16x8*)(qin + (d * 64 + 16 * s + fr) * TS + kst * 32 + fq * 8);
#pragma unroll
            for (int nt = 0; nt < 4; ++nt) { const bf16x8 ak = *(const LAS bf16x8*)(kk + (d * 64 + 16 * nt + fr) * TS + kst * 32 + fq * 8);
                sc[nt] = __builtin_amdgcn_mfma_f32_16x16x32_bf16(ak, bq, sc[nt], 0, 0, 0); } }
        { const int i = 16 * s + fr;
#pragma unroll
          for (int nt = 0; nt < 4; ++nt) { float m[4];
#pragma unroll
              for (int e = 0; e < 4; ++e) { const int j = 16 * nt + 4 * fq + e; const bool keep = d == 0 ? (j <= i) : (j > i); m[e] = keep ? sc[nt][e] : 0.f; }
              u32x2 w; w.x = pk2(m[0], m[1]); w.y = pk2(m[2], m[3]);
              *(LAS u32x2*)(sb + (d * 64 + i) * TS + 16 * nt + 4 * fq) = w; } }
        __syncthreads();
        f32x4 o[8];
#pragma unroll
        for (int nt = 0; nt < 8; ++nt) o[nt] = (f32x4){0.f, 0.f, 0.f, 0.f};
#pragma unroll
        for (int kst = 0; kst < 2; ++kst) { const bf16x8 a = *(const LAS bf16x8*)(sb + (d * 64 + 16 * s + fr) * TS + kst * 32 + fq * 8);
            const bf16x8 a2 = *(const LAS bf16x8*)(qin + (d * 64 + 16 * s + fr) * TS + kst * 32 + fq * 8);
#pragma unroll
            for (int nt = 0; nt < 8; ++nt) { const bf16x8 b = *(const LAS bf16x8*)(vT + (16 * nt + fr) * TS + ((kst * 32 + fq * 8) ^ ((nt & 7) << 3)));
                o[nt] = __builtin_amdgcn_mfma_f32_16x16x32_bf16(a, b, o[nt], 0, 0, 0);
                const bf16x8 b2 = *(const LAS bf16x8*)(hT + (d * 128 + 16 * nt + fr) * TS + kst * 32 + fq * 8);
                o[nt] = __builtin_amdgcn_mfma_f32_16x16x32_bf16(a2, b2, o[nt], 0, 0, 0); } }
        __syncthreads();
        LAS float* ob = (LAS float*)(lds + (d == 0 ? S_CUM : S_QIN));
#pragma unroll
        for (int nt = 0; nt < 8; ++nt)
#pragma unroll
            for (int r = 0; r < 4; ++r) ob[(16 * s + fq * 4 + r) * 132 + 16 * nt + fr] = o[nt][r];
        __syncthreads();
        { const LAS float* p0 = (const LAS float*)(lds + S_CUM) + tok * 132 + c16; const LAS float* p1 = (const LAS float*)(lds + S_QIN) + tok * 132 + c16;
          float v[16]; float sm = 0.f;
#pragma unroll
          for (int j = 0; j < 4; ++j) { const f32x4 a4 = *(const LAS f32x4*)(p0 + 4 * j), b4 = *(const LAS f32x4*)(p1 + 4 * j);
#pragma unroll
              for (int e = 0; e < 4; ++e) { v[4 * j + e] = a4[e] + b4[e]; sm += v[4 * j + e]; } }
          sm += __shfl_xor(sm, 1); sm += __shfl_xor(sm, 2); sm += __shfl_xor(sm, 4);
          const float mu = sm * (1.0f / 128.0f); float vs = 0.f;
#pragma unroll
          for (int j = 0; j < 16; ++j) { const float dd = v[j] - mu; vs += dd * dd; }
          vs += __shfl_xor(vs, 1); vs += __shfl_xor(vs, 2); vs += __shfl_xor(vs, 4);
          const float rstd = rsqrtf(vs * (1.0f / 128.0f) + 1e-5f);
          bf16_t* BR = (bf16_t*)(P->ws + O_PHY); bf16_t* orow = BR + (size_t)(row0 + tok) * 1536 + mx * 512 + 128 * h + c16;
          u32x4 w0, w1;
#pragma unroll
          for (int j = 0; j < 4; ++j) {
              w0[j] = pk2((v[2 * j] - mu) * rstd * silu_f(__uint_as_float(g0[j] << 16)), (v[2 * j + 1] - mu) * rstd * silu_f(__uint_as_float(g0[j] & 0xffff0000u)));
              w1[j] = pk2((v[8 + 2 * j] - mu) * rstd * silu_f(__uint_as_float(g1[j] << 16)), (v[8 + 2 * j + 1] - mu) * rstd * silu_f(__uint_as_float(g1[j] & 0xffff0000u))); }
          *(u32x4*)orow = w0; *(u32x4*)(orow + 8) = w1; }
        __syncthreads();
    }
}
DI void phase_scan2(PP4 P) {
    const int tid = otid(), bidx = obid(), G = ogrid();
    if (tid < 128) {
        for (int g = bidx * 128 + tid; g < 32768; g += G * 128) {
            const int chain = g >> 11, e4 = g & 2047, dk = (4 * e4) & 63;
            u32x2* up = (u32x2*)((bf16_t*)(P->ws + O_U) + (size_t)chain * NBLK * 8192 + 4 * e4); const float* ap = (const float*)(P->ws + O_ABUF) + (size_t)chain * NBLK * 64 + dk;
            f32x4 h = (f32x4){0.f, 0.f, 0.f, 0.f};
            for (int j0 = 0; j0 < NBLK; j0 += 20) {
                u32x2 u[20]; f32x4 a[20];
#pragma unroll
                for (int i = 0; i < 20; ++i) { u[i] = up[(size_t)(j0 + i) * 2048]; a[i] = *(const f32x4*)(ap + (j0 + i) * 64); }
#pragma unroll
                for (int i = 0; i < 20; ++i) { u32x2 w; w.x = pk2(h[0], h[1]); w.y = pk2(h[2], h[3]); up[(size_t)(j0 + i) * 2048] = w;
                    h[0] = a[i][0] * h[0] + __uint_as_float(u[i].x << 16); h[1] = a[i][1] * h[1] + __uint_as_float(u[i].x & 0xffff0000u);
                    h[2] = a[i][2] * h[2] + __uint_as_float(u[i].y << 16); h[3] = a[i][3] * h[3] + __uint_as_float(u[i].y & 0xffff0000u); }
            }
        }
    }
}

struct Hy1Regs { u32x4 p[3][3]; };
DI void hy1_load(PP4 P, int item, int tid, Hy1Regs& R) {
    const int tb = item >> 3, ct = item & 7, t0 = tb * 64, c0 = ct * 64;
    const bf16_t* PH_ = (const bf16_t*)(P->ws + O_PHY);
    const int tok = tid >> 3, c8 = (tid & 7) * 8, r = t0 + tok, c = c0 + c8;
    const bool hp = (r != 0) && (r != CTX), hn = (r != CTX - 1) && (r != RB - 1);
    const u32x4 z4 = (u32x4){0u, 0u, 0u, 0u};
#pragma unroll
    for (int gsel = 0; gsel < 3; ++gsel) { const int col = gsel * 512 + c;
        R.p[gsel][0] = hp ? *(const u32x4*)(PH_ + (size_t)(r - 1) * 1536 + col) : z4; R.p[gsel][1] = *(const u32x4*)(PH_ + (size_t)r * 1536 + col); R.p[gsel][2] = hn ? *(const u32x4*)(PH_ + (size_t)(r + 1) * 1536 + col) : z4; }
}
DI void hy1_weights(PP4 P, LAS unsigned char* lds, int l, int ct, int tid) {
    LAS float* wl = (LAS float*)(lds + 16384);
    const float* sw = P->in[I_SHW] + (size_t)l * 3 * 1536; const float* sbv = P->in[I_SHB] + l * 1536;
    __syncthreads();
    for (int idx = tid; idx < 768; idx += NT) { const int k = idx / 192, rem = idx - k * 192, gsel = rem >> 6, ch = rem & 63; const int col = gsel * 512 + ct * 64 + ch;
        wl[idx] = k == 0 ? sbv[col] : sw[(k - 1) * 1536 + col]; }
    __syncthreads();
}
DI void hy1_item(PP4 P, LAS unsigned char* lds, int l, int item, int tid, const Hy1Regs& R) {
    const int tb = item >> 3, ct = item & 7, t0 = tb * 64, c0 = ct * 64;
    bf16_t* X0 = (bf16_t*)(P->ws + O_X0C); bf16_t* ZT = (bf16_t*)(P->ws + O_ZT); float* ZC = (float*)(P->ws + O_ZCTX);
    LAS bf16_t* zt = (LAS bf16_t*)lds;
    const int tok = tid >> 3, c8 = (tid & 7) * 8, r = t0 + tok, c = c0 + c8;
    const LAS float* wl = (const LAS float*)(lds + 16384);
    float uo[3][8];
#pragma unroll
    for (int gsel = 0; gsel < 3; ++gsel) {
        const u32x4 pm = R.p[gsel][0], pc = R.p[gsel][1], pn = R.p[gsel][2];
        f32x4 wv[4][2];
#pragma unroll
        for (int k = 0; k < 2; ++k) { wv[0][k] = *(const LAS f32x4*)(wl + (0 * 3 + gsel) * 64 + c8 + 4 * k); wv[1][k] = *(const LAS f32x4*)(wl + (1 * 3 + gsel) * 64 + c8 + 4 * k); wv[2][k] = *(const LAS f32x4*)(wl + (2 * 3 + gsel) * 64 + c8 + 4 * k); wv[3][k] = *(const LAS f32x4*)(wl + (3 * 3 + gsel) * 64 + c8 + 4 * k); }
#pragma unroll
        for (int j = 0; j < 8; ++j) { const unsigned a = pm[j >> 1], b = pc[j >> 1], cw = pn[j >> 1];
            const float fa = (j & 1) ? __uint_as_float(a & 0xffff0000u) : __uint_as_float(a << 16), fb = (j & 1) ? __uint_as_float(b & 0xffff0000u) : __uint_as_float(b << 16), fc = (j & 1) ? __uint_as_float(cw & 0xffff0000u) : __uint_as_float(cw << 16);
            uo[gsel][j] = wv[0][j >> 2][j & 3] + fa * wv[1][j >> 2][j & 3] + fb * wv[2][j >> 2][j & 3] + fc * wv[3][j >> 2][j & 3]; } }
    { u32x4 w; w.x = pk2(uo[0][0], uo[0][1]); w.y = pk2(uo[0][2], uo[0][3]); w.z = pk2(uo[0][4], uo[0][5]); w.w = pk2(uo[0][6], uo[0][7]); *(u32x4*)(X0 + (size_t)r * 512 + c) = w; }
    if (t0 < CTX) {
        float* zp = ZC + (size_t)r * 512 + c;
        *(f32x4*)zp = (f32x4){uo[1][0] * uo[2][0], uo[1][1] * uo[2][1], uo[1][2] * uo[2][2], uo[1][3] * uo[2][3]}; *(f32x4*)(zp + 4) = (f32x4){uo[1][4] * uo[2][4], uo[1][5] * uo[2][5], uo[1][6] * uo[2][6], uo[1][7] * uo[2][7]};
    } else {
#pragma unroll
        for (int j = 0; j < 8; ++j) zt[(c8 + j) * TS + (tok ^ ((tid & 7) << 3))] = f2bf(uo[1][j] * uo[2][j]);
        __syncthreads();
        const int ch = tid >> 3, p8 = (tid & 7) * 8;
        *(u32x4*)(ZT + (size_t)(c0 + ch) * SEQ + (t0 - CTX) + p8) = *(const LAS u32x4*)(zt + ch * TS + (p8 ^ (((ch >> 3) & 7) << 3)));
        __syncthreads();
    }
}
DI void hy2_item(PP4 P, LAS unsigned char* lds, int c) {
    LAS cf* x = (LAS cf*)lds; const int tid = otid();
    unsigned* zrow = (unsigned*)((bf16_t*)(P->ws + O_ZT) + (size_t)c * SEQ);
    const cf* K = (const cf*)(P->ws + O_K) + (size_t)c * FM;
    { unsigned wv[16];
#pragma unroll
      for (int i = 0; i < 16; ++i) wv[i] = zrow[tid + NT * i];
#pragma unroll
      for (int i = 0; i < 16; ++i) { cf v; v.x = __uint_as_float(wv[i] << 16); v.y = __uint_as_float(wv[i] & 0xffff0000u); x[PX(tid + NT * i)] = v; cf z; z.x = 0.f; z.y = 0.f; x[PX(8192 + tid + NT * i)] = z; } }
    __syncthreads();
    fft_fwd_all(x);
    conv_pointwise(x, K, tid, NT);
    __syncthreads();
    fft_inv_all(x);
    for (int m = tid; m < 8192; m += NT) { const cf v = x[PX(m)]; zrow[m] = pk2(v.x, v.y); }
    __syncthreads();
}
DI void hy3_item(PP4 P, LAS unsigned char* lds, int item, bool last) {
    const int tid = otid(); const int tb = item >> 3, ct = item & 7, t0 = tb * 64, c0 = ct * 64;
    if (t0 < CTX && last) return;
    const bf16_t* X0 = (const bf16_t*)(P->ws + O_X0C); const bf16_t* ZT = (const bf16_t*)(P->ws + O_ZT); bf16_t* BR = (bf16_t*)(P->ws + O_PHY);
    const int tok = tid >> 3, c8 = (tid & 7) * 8, r = t0 + tok, c = c0 + c8;
    float y[8];
    if (t0 < CTX) {
        const float* ZC = (const float*)(P->ws + O_ZCTX); const float* HFC = (const float*)(P->ws + O_HFC);
        LAS float* zs = (LAS float*)lds;
        LAS float* hf = zs + 256 * 64;
#pragma unroll 8
        for (int idx = tid; idx < 256 * 64; idx += NT) { const int sidx = idx >> 6, ch = idx & 63; zs[idx] = ZC[(size_t)sidx * 512 + c0 + ch]; }
#pragma unroll 8
        for (int idx = tid; idx < 319 * 64; idx += NT) { const int li = idx >> 6, ch = idx & 63, lag = li + t0 - 255;
            hf[li * 68 + ch] = lag >= 0 ? HFC[(size_t)lag * 512 + c0 + ch] : HFC[(size_t)(256 - lag) * 512 + c0 + ch]; }
        __syncthreads();
#pragma unroll
        for (int j = 0; j < 8; ++j) y[j] = 0.f;
#pragma unroll 4
        for (int sidx = 0; sidx < CTX; ++sidx) { const int li = tok - sidx + 255;
            const f32x4 h0 = *(const LAS f32x4*)(hf + li * 68 + c8), h1 = *(const LAS f32x4*)(hf + li * 68 + c8 + 4), z0 = *(const LAS f32x4*)(zs + sidx * 64 + c8), z1 = *(const LAS f32x4*)(zs + sidx * 64 + c8 + 4);
#pragma unroll
            for (int j = 0; j < 4; ++j) { y[j] += h0[j] * z0[j]; y[4 + j] += h1[j] * z1[j]; } }
    } else {
        LAS bf16_t* yt = (LAS bf16_t*)lds;
        const int ch = tid >> 3, p8 = (tid & 7) * 8;
        *(LAS u32x4*)(yt + ch * TS + (p8 ^ (((ch >> 3) & 7) << 3))) = *(const u32x4*)(ZT + (size_t)(c0 + ch) * SEQ + (t0 - CTX) + p8);
        __syncthreads();
#pragma unroll
        for (int j = 0; j < 8; ++j) y[j] = bf2f(yt[(c8 + j) * TS + (tok ^ ((tid & 7) << 3))]);
    }
    const u32x4 xv = *(const u32x4*)(X0 + (size_t)r * 512 + c);
    float o[8];
#pragma unroll
    for (int j = 0; j < 4; ++j) { o[2 * j] = __uint_as_float(xv[j] << 16) * y[2 * j]; o[2 * j + 1] = __uint_as_float(xv[j] & 0xffff0000u) * y[2 * j + 1]; }
    u32x4 w; w.x = pk2(o[0], o[1]); w.y = pk2(o[2], o[3]); w.z = pk2(o[4], o[5]); w.w = pk2(o[6], o[7]);
    *(u32x4*)(BR + (size_t)r * 1536 + 1024 + c) = w;
    __syncthreads();
}

DI f32x2 gelu_pk(f32x2 v) {
    const f32x2 av = __builtin_elementwise_abs(v), dd = av * 0.2316418882f + 1.0f;
    f32x2 t; t.x = __builtin_amdgcn_rcpf(dd.x); t.y = __builtin_amdgcn_rcpf(dd.y);
    f32x2 q = t * 0.5307027145f + (-0.7265760135f); q = q * t + 0.7107068705f; q = q * t + (-0.142248368f); q = q * t + 0.127414796f; q = q * t;
    const f32x2 sx = (v * v) * (-0.72134752044f);
    f32x2 e; e.x = __builtin_amdgcn_exp2f(sx.x); e.y = __builtin_amdgcn_exp2f(sx.y);
    const f32x2 m = v * (q * e), r = v - m;
    f32x2 o; o.x = v.x < 0.f ? m.x : r.x; o.y = v.y < 0.f ? m.y : r.y; return o;
}
DI void cg_unpack(const u32x4 av, f32x2 (&o)[4]) {
#pragma unroll
    for (int j = 0; j < 4; ++j) { o[j].x = __uint_as_float(av[j] << 16); o[j].y = __uint_as_float(av[j] & 0xffff0000u); }
}
DI void cg_finish(const f32x2 (&acc)[4], const u32x4 vv, bf16_t* vp) {
    u32x4 w;
#pragma unroll
    for (int j = 0; j < 4; ++j) { const f32x2 gl = gelu_pk(acc[j]); w[j] = pg8::cvt_pk_bf16(gl.x * __uint_as_float(vv[j] << 16), gl.y * __uint_as_float(vv[j] & 0xffff0000u)); }
    *(u32x4*)vp = w;
}
DI void phase_convglu(PP4 P, int l) {
    const bf16_t* A = (const bf16_t*)(P->ws + O_A); bf16_t* V = (bf16_t*)(P->ws + O_V);
    const float* cw = P->in[I_FCW] + (size_t)l * 9 * DFF; const float* cb = P->in[I_FCB] + (size_t)l * DFF;
    const int gtid = obid() * NT + otid(), gstride = ogrid() * NT;
    const u32x4 z4 = (u32x4){0u, 0u, 0u, 0u};
    for (int g = gtid; g < 2 * 16 * 64 * 352; g += gstride) {
        const int ck = g % 352, r1 = g / 352, gw = r1 & 63, r2 = r1 >> 6, seg = r2 & 15, b = r2 >> 4; const int c = ck * 8;
        const size_t base = (size_t)b * RB + CTX; const bool hl = gw > 0, hr = gw < 63;
        const int gr0 = seg * 16;
        f32x2 w[9][4];
#pragma unroll
        for (int k = 0; k < 9; ++k) { const f32x4 w0 = *(const f32x4*)(cw + (size_t)k * DFF + c), w1 = *(const f32x4*)(cw + (size_t)k * DFF + c + 4);
            w[k][0] = (f32x2){w0[0], w0[1]}; w[k][1] = (f32x2){w0[2], w0[3]}; w[k][2] = (f32x2){w1[0], w1[1]}; w[k][3] = (f32x2){w1[2], w1[3]}; }
        const f32x4 b0 = *(const f32x4*)(cb + c), b1 = *(const f32x4*)(cb + c + 4);
        f32x2 wA[3][4], wB[3][4], wC[3][4];
        { const int gra = gr0 - 1; const bool ok = gra >= 0; const bf16_t* rp = A + (base + (size_t)gra * 64 + gw) * DFF + c;
          cg_unpack((ok && hl) ? *(const u32x4*)(rp - DFF) : z4, wA[0]); cg_unpack(ok ? *(const u32x4*)rp : z4, wA[1]); cg_unpack((ok && hr) ? *(const u32x4*)(rp + DFF) : z4, wA[2]);
          const bf16_t* rq = A + (base + (size_t)gr0 * 64 + gw) * DFF + c;
          cg_unpack(hl ? *(const u32x4*)(rq - DFF) : z4, wB[0]); cg_unpack(*(const u32x4*)rq, wB[1]); cg_unpack(hr ? *(const u32x4*)(rq + DFF) : z4, wB[2]); }
        u32x4 nx[3], vn;
        { const bf16_t* rp = A + (base + (size_t)(gr0 + 1) * 64 + gw) * DFF + c;
          nx[0] = hl ? *(const u32x4*)(rp - DFF) : z4; nx[1] = *(const u32x4*)rp; nx[2] = hr ? *(const u32x4*)(rp + DFF) : z4;
          vn = *(const u32x4*)(V + (base + (size_t)gr0 * 64 + gw) * DFF + c); }
#define CG_STEP(T, M, B, RR) do { const int rr_ = (RR); const int gr = gr0 + rr_; \
            cg_unpack(nx[0], B[0]); cg_unpack(nx[1], B[1]); cg_unpack(nx[2], B[2]); \
            const u32x4 vc = vn; \
            if (rr_ < 15) { const bool ok = gr + 2 < 256; const bf16_t* rp = A + (base + (size_t)(gr + 2) * 64 + gw) * DFF + c; \
                nx[0] = (ok && hl) ? *(const u32x4*)(rp - DFF) : z4; nx[1] = ok ? *(const u32x4*)rp : z4; nx[2] = (ok && hr) ? *(const u32x4*)(rp + DFF) : z4; \
                vn = *(const u32x4*)(V + (base + (size_t)(gr + 1) * 64 + gw) * DFF + c); } \
            f32x2 acc[4] = {(f32x2){b0[0], b0[1]}, (f32x2){b0[2], b0[3]}, (f32x2){b1[0], b1[1]}, (f32x2){b1[2], b1[3]}}; \
            _Pragma("unroll") for (int j = 0; j < 3; ++j) _Pragma("unroll") for (int k = 0; k < 4; ++k) { acc[k] += T[j][k] * w[j][k]; acc[k] += M[j][k] * w[3 + j][k]; acc[k] += B[j][k] * w[6 + j][k]; } \
            cg_finish(acc, vc, V + (base + (size_t)gr * 64 + gw) * DFF + c); } while (0)
        for (int r3 = 0; r3 < 15; r3 += 3) { CG_STEP(wA, wB, wC, r3); CG_STEP(wB, wC, wA, r3 + 1); CG_STEP(wC, wA, wB, r3 + 2); }
        CG_STEP(wA, wB, wC, 15);
#undef CG_STEP
    }
    for (int g = gtid; g < 2 * 256 * 352; g += gstride) {
        const int ck = g % 352, r1 = g / 352, t = r1 & 255, b = r1 >> 8; const int c = ck * 8; const size_t row = (size_t)b * RB + t;
        const f32x4 b0 = *(const f32x4*)(cb + c), b1 = *(const f32x4*)(cb + c + 4);
        f32x2 acc[4] = {(f32x2){b0[0], b0[1]}, (f32x2){b0[2], b0[3]}, (f32x2){b1[0], b1[1]}, (f32x2){b1[2], b1[3]}};
#pragma unroll
        for (int j = 0; j < 3; ++j) { const int tt = t + j - 1; if (tt < 0 || tt > 255) continue;
            f32x2 av[4]; cg_unpack(*(const u32x4*)(A + ((size_t)b * RB + tt) * DFF + c), av);
            const f32x4 w0 = *(const f32x4*)(cw + (size_t)(3 + j) * DFF + c), w1 = *(const f32x4*)(cw + (size_t)(3 + j) * DFF + c + 4);
            acc[0] += av[0] * (f32x2){w0[0], w0[1]}; acc[1] += av[1] * (f32x2){w0[2], w0[3]}; acc[2] += av[2] * (f32x2){w1[0], w1[1]}; acc[3] += av[3] * (f32x2){w1[2], w1[3]}; }
        cg_finish(acc, *(const u32x4*)(V + row * DFF + c), V + row * DFF + c);
    }
}
DI void phase_final(PP4 P) {
    const int tid = otid(), wave = tid >> 6, lane = tid & 63; const float* gam = P->in[I_FING];
    const int stride = ogrid() * 8; int R = obid() * 8 + wave;
    f32x4 v[4], vn[4];
    if (R < NB * SEQ) {
#pragma unroll
        for (int j = 0; j < 4; ++j) v[j] = *(const f32x4*)(P->out + (size_t)R * D + 256 * j + 4 * lane); }
    for (; R < NB * SEQ; R += stride) {
        if (R + stride < NB * SEQ) {
#pragma unroll
            for (int j = 0; j < 4; ++j) vn[j] = *(const f32x4*)(P->out + (size_t)(R + stride) * D + 256 * j + 4 * lane); }
        float* xr = P->out + (size_t)R * D; float s = 0.f;
#pragma unroll
        for (int j = 0; j < 4; ++j) s += v[j][0] * v[j][0] + v[j][1] * v[j][1] + v[j][2] * v[j][2] + v[j][3] * v[j][3];
        const float rs = rsqrtf(wave_sum(s) * (1.0f / 1024.0f) + 1e-6f);
#pragma unroll
        for (int j = 0; j < 4; ++j) { const int c = 256 * j + 4 * lane; __builtin_nontemporal_store(v[j] * rs * *(const f32x4*)(gam + c), (f32x4*)(xr + c)); }
#pragma unroll
        for (int j = 0; j < 4; ++j) v[j] = vn[j];
    }
}

DI int hy_pick(int scheme, int G, int b, int k) {
    if (G != 256) { const int it = b + G * k; return it < 2080 ? it : -1; }
    if (scheme == 0) { if (b < 32) return k < 4 ? 4 * b + k : -1; const int it = 96 + b + 224 * k; return it < 2080 ? it : -1; }
    if (b < 32) return k < 4 ? 32 + 4 * b + k : -1;
    if (b < 64) return k == 0 ? b - 32 : -1;
    const int it = 96 + b + 192 * k; return it < 2080 ? it : -1;
}

__global__ void __launch_bounds__(NT, 2) fwd_megakernel(Params Pk) {
    extern __shared__ __attribute__((aligned(16))) unsigned char lds_raw[];
    LAS unsigned char* lds = (LAS unsigned char*)lds_raw;
    cg::grid_group grid = cg::this_grid();
    volatile LAS unsigned* bst = (volatile LAS unsigned*)(lds + LDS_BYTES - 16);
    if (threadIdx.x == 0) { bst[0] = 0u; bst[1] = 0u; }
    __syncthreads();
    const XcdBarrier xbar = xcd_barrier_post((unsigned*)(getP()->ws + O_BAR), bst);
#define GSYNC() do { xcd_barrier(xbar); if (PROBE == 1) xcd_barrier(xbar); } while (0)
    const int G = gridDim.x, bid = blockIdx.x;
#define P getP()
#define WT ((bf16_t*)(P->ws + O_WT))
    if (PON(0)) phase_adaln(P, lds);
#pragma unroll 1
    for (int l0 = 0; l0 < 2; ++l0) {
        int l = l0; asm volatile("" : "+s"(l));
        const bool first = l == 0, last = l == 1;
        if (l == 0 || G != 256) { RPT(5) if (PON(1)) phase_wconv(P, lds, l, 0, WT_T_DN, bid, G); } else phase_wconv(P, lds, l, WT_T_UP, WT_T_DN, bid, G);
        if (l == 0 || G != 256) { RPT(7) if (PON(2)) phase_filt1(P, lds, l, bid, G); }
        if (l == 0) grid.sync(); else if (G != 256) GSYNC();
        if (PON(3)) phase_filt2(P, lds, l);
        RPT(8) if (PON(5)) phase_modulate(P, l, 0, 0, RB, (bf16_t*)(P->ws + O_H), first);
        GSYNC();
#pragma unroll 1
        for (int b0 = 0; b0 < NB; ++b0) {
            int b = b0; asm volatile("" : "+s"(b));
            { pg8::Gemm g{(const bf16_t*)(P->ws + (b == 0 ? O_H : O_U)), WT + WT_IN, 1024, 1024, 1024, 0, 0}; pg8::Sched S; S.init(RB / 256, NIN / 256, G, bid, 0, 1);
              pg8::EpiWin E{(bf16_t*)(P->ws + O_PRET), (bf16_t*)(P->ws + O_PGLA), (bf16_t*)(P->ws + O_PHY), (bf16_t*)(P->ws + O_GATES), (float*)(P->ws + O_LR)};
              RPT(2) if (PON(6)) pg8::gemm_phase(lds, g, S, E); }
            if (b == 0 && PON(4)) phase_filt3(P, lds);
            GSYNC();
            { const int tidh = otid(); int wct = -1;
              for (int k = 0;; ++k) { const int it = hy_pick(0, G, bid, k); if (it < 0) break; Hy1Regs ha; hy1_load(P, it, tidh, ha); if ((it & 7) != wct) { wct = it & 7; hy1_weights(P, lds, l, wct, tidh); } hy1_item(P, lds, l, it, tidh, ha); }
              for (int rp_ = 0; rp_ < (PROBE == 14 ? 2 : 1); ++rp_) for (int it = bid; it < 2080; it += G) scan_item<1>(P, lds, l, it); }
            GSYNC();
            if (PON(9)) for (int c = bid; c < 512; c += G) hy2_item(P, lds, c);
            if (PON(10)) phase_scan2(P);
            GSYNC();
            if (PROBE == 3) { for (int it = bid; it < 2080; it += G) scan_item<1>(P, lds, l, it); GSYNC(); phase_scan2(P); GSYNC(); }
            if (PROBE == 4) { const int tidh = otid(); Hy1Regs hc; for (int it = bid; it < 2080; it += G) { hy1_load(P, it, tidh, hc); hy1_weights(P, lds, l, it & 7, tidh); hy1_item(P, lds, l, it, tidh, hc); } GSYNC(); for (int c = bid; c < 512; c += G) hy2_item(P, lds, c); GSYNC(); }
            for (int rp_ = 0; rp_ < ((PROBE == 11 || PROBE == 13) ? 2 : 1); ++rp_)
            { if (rp_ == 0 || PROBE == 13) for (int k = 0;; ++k) { const int it = hy_pick(last ? 0 : 1, G, bid, k); if (it < 0) break; hy3_item(P, lds, it, last); }
              if (rp_ == 0 || PROBE == 11) for (int it = bid; it < 2080; it += G) { if (last && (it % (NBLK * 4)) < 16) continue;
                  scan_item<3>(P, lds, l, it); } }
            GSYNC();
            { pg8::Gemm g{(const bf16_t*)(P->ws + O_PHY), WT + WT_BR, 1536, 512, 512, 512, (long)1024 * 512}; pg8::Sched S; S.init(last ? 64 : 65, 4, G, bid, last ? 1 : 0, 3);
              pg8::EpiMerge E{(const bf16_t*)(P->ws + O_GATES), (bf16_t*)(P->ws + O_H)};
              RPT(2) if (PON(13)) pg8::gemm_phase(lds, g, S, E); }
            if (b == 0) phase_modulate(P, l, 0, RB, 2 * RB, (bf16_t*)(P->ws + O_U), first);
            if (l == 0 && b == 1 && G == 256 && bid >= 4) phase_wconv(P, lds, 1, 0, WT_T_IN, bid - 4, 252);
            GSYNC();
            { pg8::Gemm g{(const bf16_t*)(P->ws + O_H), WT + WT_OUT, 1024, 1024, 1024, 0, 0}; pg8::Sched S; S.init(last ? 64 : 65, 4, G, bid, last ? 1 : 0, 1);
              pg8::EpiRes E{first ? P->in[I_X] : P->out, P->out, first ? P->in[I_CTX] : (const float*)(P->ws + O_XCTX), (float*)(P->ws + O_XCTX), (const float*)(P->ws + O_MOD) + (size_t)l * 3 * 6144, 2048, b * RB};
              if (PON(14)) pg8::gemm_phase(lds, g, S, E); }
            if (l == 0 && b == 1 && G == 256 && bid >= 4) phase_wconv(P, lds, 1, WT_T_IN, WT_T_BR, bid - 4, 252);
            GSYNC();
        }
        RPT(8) if (PON(15)) phase_modulate(P, l, 1, 0, RT, (bf16_t*)(P->ws + O_H2), false);
        GSYNC();
        { pg8::Gemm g{(const bf16_t*)(P->ws + O_H2), WT + WT_UP, 1024, 1024, 1024, 0, 0}; pg8::Sched S; if (last) S.init(128, 22, G, bid, 0, 1, 1); else S.init(RT / 256, 22, G, bid, 0, 1);
          pg8::EpiUp E{(bf16_t*)(P->ws + O_A), (bf16_t*)(P->ws + O_V)};
          RPT(2) if (PON(16)) pg8::gemm_phase(lds, g, S, E); }
        if (l == 0 && G == 256 && bid >= 44) phase_wconv(P, lds, 1, WT_T_BR, WT_T_OUT, bid - 44, 212);
        GSYNC();
        if (PON(17)) phase_convglu(P, l);
        GSYNC();
        if (PROBE == 6) { { pg8::Gemm g{(const bf16_t*)(P->ws + O_H2), WT + WT_UP, 1024, 1024, 1024, 0, 0}; pg8::Sched S; S.init(RT / 256, 22, G, bid, 0, 1); pg8::EpiUp E{(bf16_t*)(P->ws + O_A), (bf16_t*)(P->ws + O_V)}; pg8::gemm_phase(lds, g, S, E); } GSYNC(); phase_convglu(P, l); GSYNC(); }
        { pg8::Gemm g{(const bf16_t*)(P->ws + O_V), WT + WT_DN, DFF, DFF, DFF, 0, 0}; pg8::Sched S; if (last) S.init(128, 4, G, bid, 0, 1, 1); else S.init(RT / 256, 4, G, bid, 0, 1);
          pg8::EpiRes E{P->out, P->out, (const float*)(P->ws + O_XCTX), (float*)(P->ws + O_XCTX), (const float*)(P->ws + O_MOD) + (size_t)l * 3 * 6144, 5120, 0};
          if (PON(18)) pg8::gemm_phase(lds, g, S, E); }
        if (l == 0 && G == 256 && bid >= 8) { phase_filt1(P, lds, 1, bid - 8, 248); phase_wconv(P, lds, 1, WT_T_OUT, WT_T_UP, bid - 8, 248); }
        GSYNC();
    }
    if (PON(19)) phase_final(P);
#undef P
#undef WT
}

extern "C" void kernel_launch(void* const* d_in, const int* in_sizes, int n_in, void* d_out, int out_size, void* d_ws, size_t ws_size, hipStream_t stream) {
    static int grid_blocks = 0;
    if (grid_blocks == 0) {
        if (n_in != N_INPUTS || ws_size < WS_NEED) { fprintf(stderr, "kernel_launch: unexpected inputs (%d) or workspace (%zu < %zu)\n", n_in, ws_size, (size_t)WS_NEED); grid_blocks = -1; return; }
        int dev = 0, cus = 0, per_cu = 0;
        hipGetDevice(&dev); hipDeviceGetAttribute(&cus, hipDeviceAttributeMultiprocessorCount, dev);
        if (hipFuncSetAttribute((const void*)fwd_megakernel, hipFuncAttributeMaxDynamicSharedMemorySize, LDS_BYTES) != hipSuccess) { fprintf(stderr, "kernel_launch: hipFuncSetAttribute failed\n"); }
        hipOccupancyMaxActiveBlocksPerMultiprocessor(&per_cu, (const void*)fwd_megakernel, NT, LDS_BYTES);
        if (per_cu < 1) { fprintf(stderr, "kernel_launch: occupancy query reports %d blocks per CU\n", per_cu); per_cu = 1; }
        (void)hipGetLastError();
        grid_blocks = cus;
    }
    if (grid_blocks < 0) return;
    if (hipMemsetAsync(d_ws, 0, BAR_BYTES, stream) != hipSuccess) { fprintf(stderr, "kernel_launch: memset failed\n"); return; }
    Params p{};
    for (int i = 0; i < N_INPUTS; ++i) p.in[i] = (const float*)d_in[i];
    p.out = (float*)d_out; p.ws = (unsigned char*)d_ws;
    void* args[] = {&p};
    hipError_t e = hipLaunchCooperativeKernel((const void*)fwd_megakernel, dim3(grid_blocks), dim3(NT), args, LDS_BYTES, stream);
    if (e != hipSuccess) fprintf(stderr, "cooperative launch failed: %s (grid %d)\n", hipGetErrorString(e), grid_blocks);
}
#endif
```
